# Optimizing an MI355X kernel written in HIP

```python
import math
import jax, jax.numpy as jnp
from jax import lax
import numpy as np

D_MODEL = 1024
BATCH = 4
SEQ = 8192
DEPTH = 1

CHUNK = 64
Q_BLOCK = 128
EPS = 1e-6
DA_HEADS = 8
DA_HEAD_DIM = D_MODEL // DA_HEADS // 2
DA_V_DIM = 2 * DA_HEAD_DIM
ROPE_THETA = 500000.0
ROPE_DIM = DA_HEAD_DIM // 4
SG_WIDTH = D_MODEL
SG_GROUPS = 8
SG_GROUP_DIM = SG_WIDTH // SG_GROUPS
SG_WINDOW = 128
MEM_LEN = 256
XA_HEADS = 4
XA_HEAD_DIM = D_MODEL // XA_HEADS
D_FF = 4 * D_MODEL
N_BRANCH = 2
Q_COLS = DA_HEADS * 2 * DA_HEAD_DIM
K_COLS = DA_HEADS * 2 * DA_HEAD_DIM
V_COLS = DA_HEADS * DA_V_DIM
SG_COLS = 2 * SG_WIDTH
GATE_COLS = N_BRANCH * D_MODEL
D_IN = Q_COLS + K_COLS + V_COLS + SG_COLS + GATE_COLS
SPLITS = (Q_COLS, Q_COLS + K_COLS, Q_COLS + K_COLS + V_COLS, Q_COLS + K_COLS + V_COLS + SG_COLS)

kernel_name = "hybrid_diffattn_gmlp_gated_block"


def rms_norm(x, g):
    xf = x.astype(jnp.float32)
    y = xf * lax.rsqrt(jnp.mean(xf * xf, axis=-1, keepdims=True) + EPS)
    return (y * g.astype(jnp.float32)).astype(x.dtype)


def layer_norm(x, g, b):
    xf = x.astype(jnp.float32)
    mu = jnp.mean(xf, axis=-1, keepdims=True)
    var = jnp.mean(jnp.square(xf - mu), axis=-1, keepdims=True)
    y = (xf - mu) * lax.rsqrt(var + 1e-5)
    return (y * g.astype(jnp.float32) + b.astype(jnp.float32)).astype(x.dtype)


def rope_tables(positions, dtype):
    idx = jnp.arange(0, ROPE_DIM, 2, dtype=jnp.float32)
    inv_freq = jnp.power(jnp.float32(ROPE_THETA), -idx / ROPE_DIM)
    ang = positions.astype(jnp.float32)[..., None] * inv_freq
    return (jnp.cos(ang)[:, :, None, None, :].astype(dtype),
            jnp.sin(ang)[:, :, None, None, :].astype(dtype))


def rope_partial(x, cos, sin):
    half = ROPE_DIM // 2
    x1 = x[..., :half]
    x2 = x[..., half:ROPE_DIM]
    rest = x[..., ROPE_DIM:]
    return jnp.concatenate([x1 * cos - x2 * sin, x2 * cos + x1 * sin, rest], axis=-1)


def diff_attention(q, k, v, lam):
    B, S = q.shape[0], q.shape[1]
    nb = S // Q_BLOCK
    scale = DA_HEAD_DIM ** -0.5
    k_chunk = jnp.arange(S) // CHUNK
    qb = q.reshape(B, nb, Q_BLOCK, DA_HEADS, 2, DA_HEAD_DIM).transpose(1, 0, 2, 3, 4, 5)

    def one_block(args):
        q_blk, blk = args
        q_chunk = (blk * Q_BLOCK + jnp.arange(Q_BLOCK)) // CHUNK
        mask = k_chunk[None, :] <= q_chunk[:, None]
        s = jnp.einsum('bqhmd,bkhmd->bhmqk', q_blk, k).astype(jnp.float32) * scale
        p = jax.nn.softmax(jnp.where(mask, s, -jnp.inf), axis=-1)
        a = p[:, :, 0] - lam * p[:, :, 1]
        return jnp.einsum('bhqk,bkhe->bqhe', a.astype(v.dtype), v)

    o = lax.map(one_block, (qb, jnp.arange(nb)))
    return o.transpose(1, 0, 2, 3, 4).reshape(B, S, DA_HEADS, DA_V_DIM)


def spatial_gate(z, ln_g, ln_b, w_s, b_s):
    B, S = z.shape[0], z.shape[1]
    u, v = jnp.split(z, 2, axis=-1)
    v = layer_norm(v, ln_g, ln_b)
    nw = S // SG_WINDOW
    v = v.reshape(B, nw, SG_WINDOW, SG_GROUPS, SG_GROUP_DIM)
    pos_chunk = jnp.arange(SG_WINDOW) // CHUNK
    mask = (pos_chunk[None, :] <= pos_chunk[:, None]).astype(w_s.dtype)
    v = jnp.einsum('gij,bwjgc->bwigc', w_s * mask[None], v) + b_s.T[None, None, :, :, None]
    return u * v.reshape(B, S, SG_WIDTH)


def cross_attention(h, m, w_q, w_kv, w_o):
    B, S = h.shape[0], h.shape[1]
    L = m.shape[1]
    q = (h @ w_q).reshape(B, S, XA_HEADS, XA_HEAD_DIM)
    k, v = jnp.split(m @ w_kv, 2, axis=-1)
    k = k.reshape(B, L, XA_HEADS, XA_HEAD_DIM)
    v = v.reshape(B, L, XA_HEADS, XA_HEAD_DIM)
    s = jnp.einsum('bqhd,bkhd->bhqk', q, k).astype(jnp.float32) * (XA_HEAD_DIM ** -0.5)
    p = jax.nn.softmax(s, axis=-1)
    o = jnp.einsum('bhqk,bkhd->bqhd', p.astype(v.dtype), v).reshape(B, S, D_MODEL)
    return o @ w_o


def setup_inputs(seed: int = 0) -> dict:
    key = jax.random.key(seed)
    ks = jax.random.split(key, 32)
    f32 = jnp.float32

    def nrm(k, shape, scale):
        return jax.random.normal(k, shape, f32) * scale

    def gain(k, shape):
        return 1.0 + 0.02 * jax.random.normal(k, shape, f32)

    x = jax.random.normal(ks[0], (BATCH, SEQ, D_MODEL), f32)
    mem = jax.random.normal(ks[1], (BATCH, MEM_LEN, D_MODEL), f32)
    start = jax.random.randint(ks[2], (BATCH, 1), 0, 64, dtype=jnp.int32) * CHUNK
    positions = (start + jnp.arange(SEQ, dtype=jnp.int32)[None, :]).astype(jnp.int32)
    L = DEPTH
    return {
        "x": x,
        "mem": mem,
        "positions": positions,
        "g_mix": gain(ks[3], (L, D_MODEL)),
        "w_in": nrm(ks[4], (L, D_MODEL, D_IN), D_MODEL ** -0.5),
        "lam_q1": nrm(ks[5], (L, DA_HEAD_DIM), 0.1),
        "lam_k1": nrm(ks[6], (L, DA_HEAD_DIM), 0.1),
        "lam_q2": nrm(ks[7], (L, DA_HEAD_DIM), 0.1),
        "lam_k2": nrm(ks[8], (L, DA_HEAD_DIM), 0.1),
        "g_subln": gain(ks[9], (L, DA_V_DIM)),
        "sg_ln_g": gain(ks[10], (L, SG_WIDTH)),
        "sg_ln_b": nrm(ks[11], (L, SG_WIDTH), 0.02),
        "sg_w": nrm(ks[12], (L, SG_GROUPS, SG_WINDOW, SG_WINDOW), SG_WINDOW ** -0.5),
        "sg_b": 1.0 + nrm(ks[13], (L, SG_GROUPS, SG_WINDOW), 0.01),
        "w_branch_attn": nrm(ks[14], (L, V_COLS, D_MODEL), V_COLS ** -0.5),
        "w_branch_sg": nrm(ks[15], (L, SG_WIDTH, D_MODEL), SG_WIDTH ** -0.5),
        "w_out": nrm(ks[16], (L, D_MODEL, D_MODEL), D_MODEL ** -0.5),
        "g_xa": gain(ks[17], (L, D_MODEL)),
        "g_mem": gain(ks[18], (L, D_MODEL)),
        "w_xq": nrm(ks[19], (L, D_MODEL, D_MODEL), D_MODEL ** -0.5),
        "w_xkv": nrm(ks[20], (L, D_MODEL, 2 * D_MODEL), D_MODEL ** -0.5),
        "w_xo": nrm(ks[21], (L, D_MODEL, D_MODEL), D_MODEL ** -0.5),
        "g_ffn": gain(ks[22], (L, D_MODEL)),
        "w_ff1": nrm(ks[23], (L, D_MODEL, D_FF), D_MODEL ** -0.5),
        "w_ff2": nrm(ks[24], (L, D_FF, D_MODEL), D_FF ** -0.5),
        "g_final": gain(ks[25], (D_MODEL,)),
    }


def reference(x, mem, positions, g_mix, w_in, lam_q1, lam_k1, lam_q2, lam_k2, g_subln,
              sg_ln_g, sg_ln_b, sg_w, sg_b, w_branch_attn, w_branch_sg, w_out,
              g_xa, g_mem, w_xq, w_xkv, w_xo, g_ffn, w_ff1, w_ff2, g_final):
    B, S = x.shape[0], x.shape[1]
    cos, sin = rope_tables(positions, x.dtype)
    h = x
    for l in range(DEPTH):
        n = rms_norm(h, g_mix[l])
        proj = n @ w_in[l]
        q, k, v, z, g = jnp.split(proj, SPLITS, axis=-1)
        q = rope_partial(q.reshape(B, S, DA_HEADS, 2, DA_HEAD_DIM), cos, sin)
        k = rope_partial(k.reshape(B, S, DA_HEADS, 2, DA_HEAD_DIM), cos, sin)
        v = v.reshape(B, S, DA_HEADS, DA_V_DIM)
        lam_init = 0.8 - 0.6 * math.exp(-0.3 * l)
        lam = (jnp.exp(jnp.sum(lam_q1[l].astype(jnp.float32) * lam_k1[l].astype(jnp.float32)))
               - jnp.exp(jnp.sum(lam_q2[l].astype(jnp.float32) * lam_k2[l].astype(jnp.float32)))
               + lam_init)
        a = diff_attention(q, k, v, lam)
        a = (rms_norm(a, g_subln[l]) * (1.0 - lam_init)).reshape(B, S, V_COLS)
        sgo = spatial_gate(jax.nn.gelu(z), sg_ln_g[l], sg_ln_b[l], sg_w[l], sg_b[l])
        g_a, g_s = jnp.split(jax.nn.sigmoid(g), N_BRANCH, axis=-1)
        merged = g_a * (a @ w_branch_attn[l]) + g_s * (sgo @ w_branch_sg[l])
        h = h + merged @ w_out[l]
        h = h + cross_attention(rms_norm(h, g_xa[l]), rms_norm(mem, g_mem[l]),
                                w_xq[l], w_xkv[l], w_xo[l])
        f = rms_norm(h, g_ffn[l]) @ w_ff1[l]
        h = h + jnp.square(jax.nn.relu(f)) @ w_ff2[l]
    return rms_norm(h, g_final)
```

```cpp
#include <hip/hip_runtime.h>
#include <hip/hip_cooperative_groups.h>
#include <cstdio>
#include <cstdint>
namespace cg = cooperative_groups;

#ifndef MK_COOP
#define MK_COOP 0
#endif

#define DI __device__ __forceinline__
typedef unsigned short bf16_t;
typedef short bf16x8 __attribute__((ext_vector_type(8)));
typedef short s16x4 __attribute__((ext_vector_type(4)));
typedef float f32x2 __attribute__((ext_vector_type(2)));
typedef float f32x4 __attribute__((ext_vector_type(4)));
typedef float f32x16 __attribute__((ext_vector_type(16)));
typedef unsigned u32x2 __attribute__((ext_vector_type(2)));
typedef unsigned u32x4 __attribute__((ext_vector_type(4)));
typedef __bf16 bf2_t __attribute__((ext_vector_type(2)));
typedef __attribute__((address_space(3))) unsigned char lds_t;
#define LDSP(T, p) ((__attribute__((address_space(3))) T*)(p))

constexpr int T_TOK = 32768, SEQ = 8192, DM = 1024, NTHR = 512;
constexpr float RMS_EPS = 1e-6f, LOG2E = 1.4426950408889634f;
constexpr size_t MiB = 1024 * 1024;
constexpr size_t OFF_ROPE = 0, OFF_SSQ = 2 * MiB, OFF_WM = 3 * MiB, OFF_MEMN = 4 * MiB, OFF_KVX = 6 * MiB, OFF_W = 16 * MiB, OFF_SLOT = 64 * MiB, SLOT = 64 * MiB;
constexpr size_t W_IN = 0, W_BA = 14, W_BS = 16, W_OUT = 18, W_XQ = 20, W_XKV = 22, W_XO = 26, W_FF1 = 28, W_FF2 = 36;
constexpr int SMEM_BYTES = 131072;

struct Params {
  const float *x, *mem; const int* pos;
  const float *g_mix, *w_in, *lq1, *lk1, *lq2, *lk2, *g_subln, *ln_g, *ln_b, *sg_w, *sg_b, *w_ba, *w_bs, *w_out, *g_xa, *g_mem, *w_xq, *w_xkv, *w_xo, *g_ffn, *w_ff1, *w_ff2, *g_final;
  float* out; unsigned char* ws;
};

DI unsigned pk2(float lo, float hi) { bf2_t v = __builtin_convertvector((f32x2){lo, hi}, bf2_t); return __builtin_bit_cast(unsigned, v); }
DI float bf_lo(unsigned u) { return __uint_as_float(u << 16); }
DI float bf_hi(unsigned u) { return __uint_as_float(u & 0xffff0000u); }
DI float wave_sum(float v) {
  v += __shfl_xor(v, 32); v += __shfl_xor(v, 16); v += __shfl_xor(v, 8); v += __shfl_xor(v, 4); v += __shfl_xor(v, 2); v += __shfl_xor(v, 1); return v;
}
template <class T> DI T gld(const void* base, unsigned off) { return *(const T*)((const char*)base + off); }
template <class T> DI void gst(void* base, unsigned off, T v) { *(T*)((char*)base + off) = v; }
DI bf16_t* slot(const Params& p, int i) { return (bf16_t*)(p.ws + OFF_SLOT + (size_t)i * SLOT); }
DI bf16_t* wt(const Params& p, size_t mib) { return (bf16_t*)(p.ws + OFF_W + mib * MiB); }
#define MFMA32(a, b, c) __builtin_amdgcn_mfma_f32_32x32x16_bf16((a), (b), (c), 0, 0, 0)

namespace g8 {
constexpr int BM = 256, BK = 64, HALF = 128, HTB = HALF * BK * 2, NXCD = 8, WGM = 8;
typedef f32x4 Acc[2][2][4][2];
DI int lds_byte(int r, int c) { int st = (r >> 4) * 2 + (c >> 5), rr = r & 15, cc = c & 31, ob = rr * 64 + cc * 2; return st * 1024 + (ob ^ (((ob >> 9) & 1) << 5)); }
DI void stage_rc(int b, int& R, int& C) { int st = b / 1024, sb = b % 1024, swz = sb ^ (((sb >> 9) & 1) << 5); R = (st >> 1) * 16 + swz / 64; C = (st & 1) * 32 + (swz % 64) / 2; }

DI bool tile_coords(int L, int nM, int nN, int& pm, int& pn) {
  const int nwg = nM * nN; if (L >= nwg) return false;
  int wgid = L; { const int q = nwg / NXCD, r = nwg % NXCD, xcd = wgid % NXCD, off = wgid / NXCD; wgid = (xcd < r ? xcd * (q + 1) : r * (q + 1) + (xcd - r) * q) + off; }
  const int nig = WGM * nN, gid = wgid / nig, fm = gid * WGM, gsz = (nM - fm) < WGM ? (nM - fm) : WGM;
  pm = fm + ((wgid % nig) % gsz); pn = (wgid % nig) / gsz; return true;
}

DI void kloop(const bf16_t* __restrict__ A, const bf16_t* __restrict__ Bt, int K, int brow, int bcol, Acc& acc, lds_t* lds) {
  const int tid = threadIdx.x, wid = __builtin_amdgcn_readfirstlane(tid >> 6), lane = tid & 63, wr = wid >> 2, wc = wid & 3, fr = lane & 15, fq = lane >> 4;
  unsigned voff[2];
#pragma unroll
  for (int i = 0; i < 2; ++i) { int R, C; stage_rc(tid * 16 + i * 8192, R, C); voff[i] = (unsigned)(R * K + C) * 2u; }
  const size_t kstep = (size_t)(BK * 2), hstep = (size_t)HALF * K * 2;
  const unsigned ldsw = (unsigned)wid * 1024u;
  const int aoff = lds_byte(wr * 64 + fr, fq * 8), boff = lds_byte(wc * 32 + fr, fq * 8);
  const char* cA = (const char*)A + (size_t)brow * K * 2; const char* cB = (const char*)Bt + (size_t)bcol * K * 2;
#define SA(b, h) (((b) * 2 + (h)) * HTB)
#define SB(b, h) ((4 + (b) * 2 + (h)) * HTB)
#define STAGE(bufoff, gbase) do { _Pragma("unroll") for (int _i = 0; _i < 2; ++_i) \
    __builtin_amdgcn_global_load_lds((const __attribute__((address_space(1))) unsigned*)((const char*)(gbase) + voff[_i]), LDSP(unsigned, lds + (bufoff) + ldsw + _i * 8192), 16, 0, 0); } while (0)
#define LDA(dst, b, h) do { _Pragma("unroll") for (int m = 0; m < 4; ++m) _Pragma("unroll") for (int k = 0; k < 2; ++k) dst[m][k] = *LDSP(const bf16x8, lds + SA(b, h) + aoff + m * 2048 + k * 1024); } while (0)
#define LDB(dst, b, h) do { _Pragma("unroll") for (int n = 0; n < 2; ++n) _Pragma("unroll") for (int k = 0; k < 2; ++k) dst[n][k] = *LDSP(const bf16x8, lds + SB(b, h) + boff + n * 2048 + k * 1024); } while (0)
#define MMA(ai, bj, AT, BT) do { __builtin_amdgcn_s_setprio(1); \
    _Pragma("unroll") for (int m = 0; m < 4; ++m) _Pragma("unroll") for (int n = 0; n < 2; ++n) _Pragma("unroll") for (int k = 0; k < 2; ++k) \
      acc[ai][bj][m][n] = __builtin_amdgcn_mfma_f32_16x16x32_bf16(BT[n][k], AT[m][k], acc[ai][bj][m][n], 0, 0, 0); \
    __builtin_amdgcn_s_setprio(0); } while (0)
#define WAIT_V(n) asm volatile("s_waitcnt vmcnt(" #n ")" ::: "memory")
#define WAIT_L(n) asm volatile("s_waitcnt lgkmcnt(" #n ")" ::: "memory")
#define BAR __builtin_amdgcn_s_barrier()
#define SCHED __builtin_amdgcn_sched_barrier(0)
  bf16x8 At[4][2], B0[2][2], B1[2][2];
  const int nt = K / BK;
  STAGE(SB(0, 0), cB); STAGE(SA(0, 0), cA);
  STAGE(SB(0, 1), cB + hstep); STAGE(SA(0, 1), cA + hstep);
  if (wr == 1) BAR;
  WAIT_V(4); BAR;
  STAGE(SB(1, 0), cB + kstep); STAGE(SA(1, 0), cA + kstep); STAGE(SB(1, 1), cB + hstep + kstep);
  WAIT_V(6); BAR;
  for (int t = 0; t < nt - 2; t += 2) {
    const char* a1 = cA + (size_t)(t + 1) * kstep; const char* a2 = cA + (size_t)(t + 2) * kstep; const char* a3 = cA + (size_t)(t + 3) * kstep;
    const char* b2 = cB + (size_t)(t + 2) * kstep; const char* b3 = cB + (size_t)(t + 3) * kstep;
    LDB(B0, 0, 0); SCHED; LDA(At, 0, 0); STAGE(SA(1, 1), a1 + hstep);
    WAIT_L(8); BAR; WAIT_L(0); MMA(0, 0, At, B0); BAR; SCHED;
    LDB(B1, 0, 1); STAGE(SB(0, 0), b2);
    BAR; WAIT_L(0); MMA(0, 1, At, B1); BAR;
    LDA(At, 0, 1); STAGE(SA(0, 0), a2);
    BAR; WAIT_L(0); MMA(1, 0, At, B0); BAR; SCHED;
    STAGE(SB(0, 1), b2 + hstep);
    WAIT_V(6); BAR; MMA(1, 1, At, B1); BAR;
    LDB(B0, 1, 0); SCHED; LDA(At, 1, 0); STAGE(SA(0, 1), a2 + hstep);
    WAIT_L(8); BAR; WAIT_L(0); MMA(0, 0, At, B0); BAR; SCHED;
    LDB(B1, 1, 1); STAGE(SB(1, 0), b3);
    BAR; WAIT_L(0); MMA(0, 1, At, B1); BAR;
    LDA(At, 1, 1); STAGE(SA(1, 0), a3);
    BAR; WAIT_L(0); MMA(1, 0, At, B0); BAR; SCHED;
    STAGE(SB(1, 1), b3 + hstep);
    WAIT_V(6); BAR; MMA(1, 1, At, B1); BAR;
  }
  { LDB(B0, 0, 0); LDA(At, 0, 0); STAGE(SA(1, 1), cA + (size_t)(nt - 1) * kstep + hstep);
    BAR; WAIT_L(0); MMA(0, 0, At, B0); BAR;
    LDB(B1, 0, 1); BAR; WAIT_L(0); MMA(0, 1, At, B1); BAR;
    LDA(At, 0, 1); WAIT_V(4); BAR; WAIT_L(0); MMA(1, 0, At, B0); MMA(1, 1, At, B1); BAR; }
  { LDB(B0, 1, 0); LDA(At, 1, 0); WAIT_V(2); BAR; WAIT_L(0); MMA(0, 0, At, B0); BAR;
    LDB(B1, 1, 1); WAIT_V(0); BAR; WAIT_L(0); MMA(0, 1, At, B1); BAR;
    LDA(At, 1, 1); BAR; WAIT_L(0); MMA(1, 0, At, B0); MMA(1, 1, At, B1); BAR; }
  if (wr == 0) BAR;
#undef SA
#undef SB
#undef STAGE
#undef LDA
#undef LDB
#undef MMA
}

DI void zero_acc(Acc& acc) {
#pragma unroll
  for (int a = 0; a < 2; ++a)
#pragma unroll
    for (int b = 0; b < 2; ++b)
#pragma unroll
      for (int m = 0; m < 4; ++m)
#pragma unroll
        for (int n = 0; n < 2; ++n) acc[a][b][m][n] = (f32x4){0.f, 0.f, 0.f, 0.f};
}

template <class F> DI void epi_loop(Acc& acc, int pm, int pn, int wr, int wc, int fr, int fq, F&& f) {
#pragma unroll
  for (int ai = 0; ai < 2; ++ai)
#pragma unroll
    for (int m = 0; m < 4; ++m) {
      const int row = pm * BM + ai * HALF + wr * 64 + m * 16 + fr;
#pragma unroll
      for (int bj = 0; bj < 2; ++bj)
#pragma unroll
        for (int n = 0; n < 2; ++n) { const int col = pn * BM + bj * HALF + wc * 32 + n * 16 + fq * 4; f(row, col, n, acc[ai][bj][m][n]); }
      __builtin_amdgcn_sched_barrier(0);
    }
}

template <class Epi> DI void gemm_phase(const bf16_t* A, const bf16_t* Bt, int M, int N, int K, const Epi& epi, lds_t* shm) {
  const int nM = M / BM, nN = N / BM;
  const int wid = __builtin_amdgcn_readfirstlane(threadIdx.x >> 6), lane = threadIdx.x & 63, wr = wid >> 2, wc = wid & 3, fr = lane & 15, fq = lane >> 4;
  for (int i = 0;; ++i) {
    int pm, pn; if (!tile_coords(i * (int)gridDim.x + (int)blockIdx.x, nM, nN, pm, pn)) break;
    Acc acc; zero_acc(acc);
    kloop(A, Bt, K, pm * BM, pn * BM, acc, shm);
    epi(acc, pm, pn, wr, wc, fr, fq);
  }
}
}

DI void st_bf4(bf16_t* p, f32x4 v) { u32x2 w; w.x = pk2(v[0], v[1]); w.y = pk2(v[2], v[3]); *(u32x2*)p = w; }

struct EpiProj {
  Params p;
  DI void operator()(g8::Acc& acc, int pm, int pn, int wr, int wc, int fr, int fq) const {
    using namespace g8;
    const int seg = pn >> 2;
    const float* rope = (const float*)(p.ws + OFF_ROPE);
    bf16_t* dst; int ld, cofs;
    if (seg < 5) { dst = slot(p, seg + 1); ld = 1024; cofs = seg * 1024; } else { dst = (bf16_t*)p.out; ld = 2048; cofs = 5 * 1024; }
    const bool dorope = (seg < 2) && ((wc & 1) == 0);
    const float qs = (seg == 0) ? 0.125f * LOG2E : 1.0f;
    epi_loop(acc, pm, pn, wr, wc, fr, fq, [&](int row, int col, int n, f32x4& v) __attribute__((always_inline)) {
      f32x4 o = v;
      if (seg < 2) {
        if (dorope && n == 0) {
          const f32x4 cs = *(const f32x4*)(rope + (size_t)row * 16 + (fq & 1) * 4), sn = *(const f32x4*)(rope + (size_t)row * 16 + 8 + (fq & 1) * 4);
          f32x4 pr; pr[0] = __shfl_xor(v[0], 32); pr[1] = __shfl_xor(v[1], 32); pr[2] = __shfl_xor(v[2], 32); pr[3] = __shfl_xor(v[3], 32);
          if (fq < 2) o = v * cs - pr * sn; else o = v * cs + pr * sn;
        }
        o = o * qs;
      } else if (seg == 3 || seg == 4) {
#pragma unroll
        for (int e = 0; e < 4; ++e) { const float xx = v[e], y = 0.7978845608028654f * (xx + 0.044715f * xx * xx * xx); o[e] = xx / (1.0f + __expf(-2.0f * y)); }
      } else if (seg >= 5) {
#pragma unroll
        for (int e = 0; e < 4; ++e) o[e] = 1.0f / (1.0f + __expf(-v[e]));
      }
      st_bf4(dst + (size_t)row * ld + (col - cofs), o);
    });
  }
};

struct EpiPlainBf16 {
  bf16_t* dst; int ld;
  DI void operator()(g8::Acc& acc, int pm, int pn, int wr, int wc, int fr, int fq) const {
    using namespace g8;
    epi_loop(acc, pm, pn, wr, wc, fr, fq, [&](int row, int col, int n, f32x4& v) __attribute__((always_inline)) { st_bf4(dst + (size_t)row * ld + col, v); });
  }
};

struct EpiResid {
  const float* res; float* out; bf16_t* outb; float* ssq;
  DI void operator()(g8::Acc& acc, int pm, int pn, int wr, int wc, int fr, int fq) const {
    using namespace g8;
#pragma unroll
    for (int ai = 0; ai < 2; ++ai)
#pragma unroll
      for (int m = 0; m < 4; ++m) {
        const int row = pm * BM + ai * HALF + wr * 64 + m * 16 + fr; float s = 0.f;
#pragma unroll
        for (int bj = 0; bj < 2; ++bj)
#pragma unroll
          for (int n = 0; n < 2; ++n) {
            const int col = pn * BM + bj * HALF + wc * 32 + n * 16 + fq * 4;
            const f32x4 r = *(const f32x4*)(res + (size_t)row * DM + col); const f32x4 o = r + acc[ai][bj][m][n];
            *(f32x4*)(out + (size_t)row * DM + col) = o;
            if (outb) st_bf4(outb + (size_t)row * DM + col, o);
            s += o[0] * o[0] + o[1] * o[1] + o[2] * o[2] + o[3] * o[3];
          }
        s += __shfl_xor(s, 16); s += __shfl_xor(s, 32);
        if (fq == 0) atomicAdd(ssq + row, s);
      }
  }
};

struct EpiRowScale {
  bf16_t* dst; int ld; const float* ssq; float sc; int act;
  DI void operator()(g8::Acc& acc, int pm, int pn, int wr, int wc, int fr, int fq) const {
    using namespace g8;
#pragma unroll
    for (int ai = 0; ai < 2; ++ai)
#pragma unroll
      for (int m = 0; m < 4; ++m) {
        const int row = pm * BM + ai * HALF + wr * 64 + m * 16 + fr; const float rs = rsqrtf(ssq[row] * (1.0f / DM) + RMS_EPS) * sc;
#pragma unroll
        for (int bj = 0; bj < 2; ++bj)
#pragma unroll
          for (int n = 0; n < 2; ++n) {
            const int col = pn * BM + bj * HALF + wc * 32 + n * 16 + fq * 4; f32x4 o = acc[ai][bj][m][n] * rs;
            if (act) {
#pragma unroll
              for (int e = 0; e < 4; ++e) { const float r = fmaxf(o[e], 0.f); o[e] = r * r; } }
            st_bf4(dst + (size_t)row * ld + col, o);
          }
      }
  }
};

struct EpiGate {
  bf16_t* dst; const bf16_t* gates; int gofs; int add;
  DI void operator()(g8::Acc& acc, int pm, int pn, int wr, int wc, int fr, int fq) const {
    using namespace g8;
    epi_loop(acc, pm, pn, wr, wc, fr, fq, [&](int row, int col, int n, f32x4& v) __attribute__((always_inline)) {
      const unsigned go = ((unsigned)row * 2048u + (unsigned)(gofs + col)) * 2u, oo = ((unsigned)row * 1024u + (unsigned)col) * 2u;
      const u32x2 g = gld<u32x2>(gates, go);
      f32x4 o; o[0] = v[0] * bf_lo(g.x); o[1] = v[1] * bf_hi(g.x); o[2] = v[2] * bf_lo(g.y); o[3] = v[3] * bf_hi(g.y);
      if (add) { const u32x2 t = gld<u32x2>(dst, oo); o[0] += bf_lo(t.x); o[1] += bf_hi(t.x); o[2] += bf_lo(t.y); o[3] += bf_hi(t.y); }
      u32x2 w; w.x = pk2(o[0], o[1]); w.y = pk2(o[2], o[3]); gst<u32x2>(dst, oo, w);
    });
  }
};
DI void merged_phase(const Params& p, lds_t* shm) {
  g8::gemm_phase(slot(p, 0), wt(p, W_BA), T_TOK, DM, DM, EpiGate{slot(p, 1), (const bf16_t*)p.out, 0, 0}, shm);
  g8::gemm_phase(slot(p, 4), wt(p, W_BS), T_TOK, DM, DM, EpiGate{slot(p, 1), (const bf16_t*)p.out, 1024, 1}, shm);
}

DI void wt_transpose(const float* W, bf16_t* Wt, const float* gain, int K, int N, lds_t* shm) {
  const int tk = K / 64, tn = N / 64, tid = threadIdx.x;
  __attribute__((address_space(3))) float* tile = LDSP(float, shm);
  for (int t = blockIdx.x; t < tk * tn; t += gridDim.x) {
    const int k0 = (t / tn) * 64, n0 = (t % tn) * 64;
    const int r = tid >> 4, c4 = (tid & 15) * 4;
#pragma unroll
    for (int i = 0; i < 2; ++i) {
      const int kk = r + 32 * i; f32x4 v = *(const f32x4*)(W + (size_t)(k0 + kk) * N + n0 + c4);
      if (gain) v = v * gain[k0 + kk];
      tile[kk * 65 + c4 + 0] = v[0]; tile[kk * 65 + c4 + 1] = v[1]; tile[kk * 65 + c4 + 2] = v[2]; tile[kk * 65 + c4 + 3] = v[3];
    }
    __syncthreads();
    const int nn = tid >> 3, k8 = (tid & 7) * 8;
    u32x4 w;
    w.x = pk2(tile[(k8 + 0) * 65 + nn], tile[(k8 + 1) * 65 + nn]); w.y = pk2(tile[(k8 + 2) * 65 + nn], tile[(k8 + 3) * 65 + nn]);
    w.z = pk2(tile[(k8 + 4) * 65 + nn], tile[(k8 + 5) * 65 + nn]); w.w = pk2(tile[(k8 + 6) * 65 + nn], tile[(k8 + 7) * 65 + nn]);
    *(u32x4*)(Wt + (size_t)(n0 + nn) * K + k0 + k8) = w;
    __syncthreads();
  }
}

DI void rms_rows(const float* X, const float* g, bf16_t* out, int nrows) {
  const int wid = threadIdx.x >> 6, lane = threadIdx.x & 63;
  for (int r = blockIdx.x * 8 + wid; r < nrows; r += gridDim.x * 8) {
    const f32x4* xr = (const f32x4*)(X + (size_t)r * DM); f32x4 v[4]; float ss = 0.f;
#pragma unroll
    for (int i = 0; i < 4; ++i) { v[i] = xr[lane + 64 * i]; ss += v[i][0] * v[i][0] + v[i][1] * v[i][1] + v[i][2] * v[i][2] + v[i][3] * v[i][3]; }
    ss = wave_sum(ss); const float rs = rsqrtf(ss * (1.0f / DM) + RMS_EPS);
#pragma unroll
    for (int i = 0; i < 4; ++i) { const f32x4 gg = ((const f32x4*)g)[lane + 64 * i]; st_bf4(out + (size_t)r * DM + (lane + 64 * i) * 4, v[i] * rs * gg); }
  }
}

DI void prep_phase(const Params& p, lds_t* shm) {
  const int gt = blockIdx.x * NTHR + threadIdx.x, gn = gridDim.x * NTHR;
  float* rope = (float*)(p.ws + OFF_ROPE);
  for (int i = gt; i < T_TOK * 8; i += gn) {
    const int t = i >> 3, f = i & 7; const float inv = (float)exp2(-(double)f * 0.125 * 18.931568569324174  );
    const float ang = (float)p.pos[t] * inv; float s, c; sincosf(ang, &s, &c); rope[t * 16 + f] = c; rope[t * 16 + 8 + f] = s;
  }
  float* ssq = (float*)(p.ws + OFF_SSQ);
  for (int i = gt; i < 3 * T_TOK; i += gn) ssq[i] = 0.f;
  bf16_t* wm = (bf16_t*)(p.ws + OFF_WM);
  for (int i = gt; i < 8 * 128 * 128 / 2; i += gn) {
    const int e = i * 2, ii = (e >> 7) & 127, j = e & 127; const f32x2 w = *(const f32x2*)(p.sg_w + e);
    const bool ok = (j >> 6) <= (ii >> 6); ((unsigned*)wm)[i] = ok ? pk2(w[0], w[1]) : 0u;
  }
  rms_rows(p.x, p.g_mix, slot(p, 0), T_TOK);
  rms_rows(p.mem, p.g_mem, (bf16_t*)(p.ws + OFF_MEMN), 1024);
  wt_transpose(p.w_in, wt(p, W_IN), nullptr, 1024, 7168, shm);
  wt_transpose(p.w_ba, wt(p, W_BA), nullptr, 1024, 1024, shm);
  wt_transpose(p.w_bs, wt(p, W_BS), nullptr, 1024, 1024, shm);
  wt_transpose(p.w_out, wt(p, W_OUT), nullptr, 1024, 1024, shm);
  wt_transpose(p.w_xq, wt(p, W_XQ), p.g_xa, 1024, 1024, shm);
  wt_transpose(p.w_xkv, wt(p, W_XKV), nullptr, 1024, 2048, shm);
  wt_transpose(p.w_xo, wt(p, W_XO), nullptr, 1024, 1024, shm);
  wt_transpose(p.w_ff1, wt(p, W_FF1), p.g_ffn, 1024, 4096, shm);
  wt_transpose(p.w_ff2, wt(p, W_FF2), nullptr, 4096, 1024, shm);
}

DI unsigned off_a(unsigned row, unsigned ch) { return 2048u * (row >> 3) + 512u * (ch >> 2) + 64u * (row & 7) + 16u * ((ch & 3) ^ ((row >> 2) & 3)); }
DI void inv_off_a(unsigned L, unsigned& row, unsigned& ch) {
  const unsigned o = L * 16u, b8 = o >> 11, rem = o & 2047u, chq = rem >> 9, rem2 = rem & 511u, r7 = rem2 >> 6, cx = (rem2 & 63u) >> 4;
  row = b8 * 8 + r7; ch = chq * 4 + (cx ^ ((row >> 2) & 3));
}
DI bf16x8 tr_pair(lds_t* a0, lds_t* a1) {
  const s16x4 lo = __builtin_amdgcn_ds_read_tr16_b64_v4i16(LDSP(s16x4, a0)), hi = __builtin_amdgcn_ds_read_tr16_b64_v4i16(LDSP(s16x4, a1));
  return __builtin_shufflevector(lo, hi, 0, 1, 2, 3, 4, 5, 6, 7);
}

DI void glds16(const void* base, unsigned off, lds_t* dst) {
  __builtin_amdgcn_global_load_lds((const __attribute__((address_space(1))) unsigned*)((const char*)base + off), LDSP(unsigned, dst), 16, 0, 0);
}

template <int DH, int KW, int DV, int MODE, bool QLDS>
DI void attn_unit(const bf16_t* __restrict__ Qg, const bf16_t* __restrict__ Kg, const bf16_t* __restrict__ Vg, int ldq, int ldkv,
                  bf16_t* __restrict__ Og, int ldo, int ntiles, int wave_tiles, unsigned kmo, float lam, const float* __restrict__ gsub, lds_t* shm) {
  constexpr int KIMG = KW / 128, VIMG = DV / 128, KS = DH / 16, NC = DV / 32;
  constexpr int STAGE_B = (KIMG + VIMG) * 16384;
  const int tid = threadIdx.x, lane = tid & 63, h = lane >> 5, l31 = lane & 31, wid = __builtin_amdgcn_readfirstlane(tid >> 6);
  unsigned soff[2];
#pragma unroll
  for (int i = 0; i < 2; ++i) { unsigned r, c; inv_off_a(tid + 512 * i, r, c); soff[i] = (r * (unsigned)ldkv + c * 8u) * 2u; }
  const unsigned tstep = 64u * (unsigned)ldkv * 2u;
  auto issue = [&](int kt, int st) __attribute__((always_inline)) {
    lds_t* base = shm + st * STAGE_B + wid * 1024;
    const char* kb = (const char*)Kg + (size_t)kt * tstep; const char* vb = (const char*)Vg + (size_t)kt * tstep;
#pragma unroll
    for (int im = 0; im < KIMG; ++im)
#pragma unroll
      for (int i = 0; i < 2; ++i) glds16(kb + im * 256, soff[i], base + im * 16384 + i * 8192);
#pragma unroll
    for (int im = 0; im < VIMG; ++im)
#pragma unroll
      for (int i = 0; i < 2; ++i) glds16(vb + im * 256, soff[i], base + (KIMG + im) * 16384 + i * 8192);
  };
  __syncthreads();
  issue(0, 0);
  lds_t* Qst = shm + 2 * STAGE_B + wid * 8192;
  if (QLDS) {
#pragma unroll
    for (int i = 0; i < 8; ++i) { unsigned r, c; inv_off_a(lane + 64 * i, r, c); glds16(Qg, (r * (unsigned)ldq + c * 8u) * 2u, Qst + i * 1024); }
  }
  const unsigned qoff = ((unsigned)l31 * (unsigned)ldq + 8u * h) * 2u;
  f32x16 O[NC];
#pragma unroll
  for (int c = 0; c < NC; ++c)
#pragma unroll
    for (int i = 0; i < 16; ++i) O[c][i] = 0.f;
  float mrun = -INFINITY, lrun = 0.f;
  const unsigned q4 = (lane & 15) >> 2, pp = lane & 3, blk = (lane >> 4) & 1;
  const unsigned xk = (l31 >> 2) & 3, kbase = 2048u * (l31 >> 3) + 64u * (l31 & 7) + kmo;
  const unsigned ka0 = kbase + 16u * ((unsigned)h ^ xk), ka2 = kbase + 16u * ((2u + h) ^ xk);
  const unsigned vrow = 64u * (4u * h + q4), cl = 2u * blk + (pp >> 1);
  const unsigned va0 = vrow + 16u * (cl ^ (unsigned)h) + 8u * (pp & 1), va1 = vrow + 16u * (cl ^ ((unsigned)h ^ 2u)) + 8u * (pp & 1);

  for (int kt = 0; kt < ntiles; ++kt) {
    asm volatile("s_waitcnt vmcnt(0)" ::: "memory");
    __syncthreads();
    if (kt + 1 < ntiles) issue(kt + 1, (kt + 1) & 1);
    const float msk = (kt < wave_tiles) ? 0.f : -INFINITY;
    const unsigned so = (kt & 1) * STAGE_B;
    lds_t* K0 = shm + (so + ka0); lds_t* K2 = shm + (so + ka2); lds_t* V0 = shm + (so + KIMG * 16384 + va0); lds_t* V1 = shm + (so + KIMG * 16384 + va1);
    f32x16 s[2];
#pragma unroll
    for (int kb = 0; kb < 2; ++kb)
#pragma unroll
      for (int i = 0; i < 16; ++i) s[kb][i] = 0.f;
#pragma unroll
    for (int ss = 0; ss < KS; ++ss) {
      const int cgl = 2 * ss, img = cgl >> 4;
      const bf16x8 qv = QLDS ? *LDSP(const bf16x8, Qst + ((cgl & 2) ? ka2 : ka0) + 512 * ((cgl & 15) >> 2)) : gld<bf16x8>(Qg + 16 * ss, qoff);
#pragma unroll
      for (int kb = 0; kb < 2; ++kb) {
        const bf16x8 kf = *LDSP(const bf16x8, ((cgl & 2) ? K2 : K0) + img * 16384 + kb * 8192 + 512 * ((cgl & 15) >> 2));
        s[kb] = MFMA32(kf, qv, s[kb]);
      }
    }
    __builtin_amdgcn_sched_barrier(0);
    float mx = s[0][0];
#pragma unroll
    for (int i = 1; i < 16; ++i) mx = fmaxf(mx, s[0][i]);
#pragma unroll
    for (int i = 0; i < 16; ++i) mx = fmaxf(mx, s[1][i]);
    mx = fmaxf(mx, __shfl_xor(mx, 32)) + msk;
    const float mnew = fmaxf(mrun, mx), alpha = __builtin_amdgcn_exp2f(mrun - mnew), msub = mnew - msk; mrun = mnew;
    float rs = 0.f;
#pragma unroll
    for (int kb = 0; kb < 2; ++kb)
#pragma unroll
      for (int i = 0; i < 16; ++i) { const float e = __builtin_amdgcn_exp2f(s[kb][i] - msub); s[kb][i] = e; rs += e; }
    lrun = lrun * alpha + rs;
    bf16x8 P[2][2];
#pragma unroll
    for (int kb = 0; kb < 2; ++kb)
#pragma unroll
      for (int s2 = 0; s2 < 2; ++s2) {
        u32x4 w; w.x = pk2(s[kb][8 * s2 + 0], s[kb][8 * s2 + 1]); w.y = pk2(s[kb][8 * s2 + 2], s[kb][8 * s2 + 3]);
        w.z = pk2(s[kb][8 * s2 + 4], s[kb][8 * s2 + 5]); w.w = pk2(s[kb][8 * s2 + 6], s[kb][8 * s2 + 7]);
        P[kb][s2] = __builtin_bit_cast(bf16x8, w);
      }
#pragma unroll
    for (int c = 0; c < NC; ++c) O[c] = O[c] * alpha;
    __builtin_amdgcn_sched_barrier(0);
#pragma unroll
    for (int ks = 0; ks < 4; ++ks) {
#pragma unroll
      for (int c = 0; c < NC; ++c) {
        const int vo = (c >> 2) * 16384 + 512 * (c & 3) + 4096 * ks;
        const bf16x8 vf = tr_pair(V0 + vo, V1 + vo + 2048);
        O[c] = MFMA32(vf, P[ks >> 1][ks & 1], O[c]);
      }
      __builtin_amdgcn_sched_barrier(0);
    }
  }
  const float l = lrun + __shfl_xor(lrun, 32); float inv = 1.0f / l;
  const unsigned ooff = ((unsigned)l31 * (unsigned)ldo + 4u * h) * 2u;
  if (MODE == 2) {
    float ssq = 0.f; inv *= lam;
#pragma unroll
    for (int c = 0; c < NC; ++c)
#pragma unroll
      for (int g4 = 0; g4 < 4; ++g4) {
        const u32x2 t = gld<u32x2>(Og + 32 * c + 8 * g4, ooff);
        const float a0 = bf_lo(t.x) - O[c][4 * g4 + 0] * inv, a1 = bf_hi(t.x) - O[c][4 * g4 + 1] * inv, a2 = bf_lo(t.y) - O[c][4 * g4 + 2] * inv, a3 = bf_hi(t.y) - O[c][4 * g4 + 3] * inv;
        O[c][4 * g4 + 0] = a0; O[c][4 * g4 + 1] = a1; O[c][4 * g4 + 2] = a2; O[c][4 * g4 + 3] = a3;
        ssq += a0 * a0 + a1 * a1 + a2 * a2 + a3 * a3;
      }
    ssq += __shfl_xor(ssq, 32);
    inv = rsqrtf(ssq * (1.0f / DV) + RMS_EPS) * 0.8f;
  }
#pragma unroll
  for (int c = 0; c < NC; ++c)
#pragma unroll
    for (int g4 = 0; g4 < 4; ++g4) {
      const int dv0 = 32 * c + 8 * g4; f32x4 o;
#pragma unroll
      for (int e = 0; e < 4; ++e) o[e] = O[c][4 * g4 + e] * inv;
      if (MODE == 2) o = o * gld<f32x4>(gsub + dv0, 16u * h);
      u32x2 w; w.x = pk2(o[0], o[1]); w.y = pk2(o[2], o[3]);
      gst<u32x2>(Og + dv0, ooff, w);
    }
}

DI void diff_attn_phase(const Params& p, lds_t* shm) {
  const int wid = __builtin_amdgcn_readfirstlane(threadIdx.x >> 6), lane = threadIdx.x & 63;
  const float d1 = wave_sum(p.lq1[lane] * p.lk1[lane]), d2 = wave_sum(p.lq2[lane] * p.lk2[lane]);
  const float lam = expf(d1) - expf(d2) + 0.2f;
  const bf16_t *Q = slot(p, 1), *K = slot(p, 2), *V = slot(p, 3); bf16_t* A = slot(p, 0);
  for (int pi = blockIdx.x; pi < 512; pi += gridDim.x) {
    const int bh = pi >> 4, pp = pi & 15, b = bh >> 3, hd = bh & 7;
    for (int e = 0; e < 2; ++e) {
      const int qb = e ? 31 - pp : pp; const size_t r0 = (size_t)b * SEQ + qb * 256 + wid * 32;
      attn_unit<64, 128, 128, 0, true>(Q + r0 * DM + hd * 128, K + (size_t)b * SEQ * DM + hd * 128, V + (size_t)b * SEQ * DM + hd * 128, DM, DM,
                                       A + r0 * DM + hd * 128, DM, qb * 4 + 4, qb * 4 + (wid >> 1) + 1, 0u, lam, p.g_subln, shm);
      attn_unit<64, 128, 128, 2, true>(Q + r0 * DM + hd * 128, K + (size_t)b * SEQ * DM + hd * 128, V + (size_t)b * SEQ * DM + hd * 128, DM, DM,
                                       A + r0 * DM + hd * 128, DM, qb * 4 + 4, qb * 4 + (wid >> 1) + 1, 1024u, lam, p.g_subln, shm);
    }
  }
}

DI void cross_attn_phase(const Params& p, lds_t* shm) {
  const int wid = __builtin_amdgcn_readfirstlane(threadIdx.x >> 6);
  const bf16_t* Q = slot(p, 3); const bf16_t* KV = (const bf16_t*)(p.ws + OFF_KVX); bf16_t* O = slot(p, 0);
  for (int u = blockIdx.x; u < 512; u += gridDim.x) {
    const int bh = u >> 5, qb = u & 31, b = bh >> 2, hd = bh & 3; const size_t r0 = (size_t)b * SEQ + qb * 256 + wid * 32;
    attn_unit<256, 256, 256, 0, false>(Q + r0 * DM + hd * 256, KV + (size_t)b * 256 * 2048 + hd * 256, KV + (size_t)b * 256 * 2048 + 1024 + hd * 256, DM, 2048,
                                       O + r0 * DM + hd * 256, DM, 4, 4, 0u, 0.f, nullptr, shm);
  }
}

DI void sg_phase(const Params& p, lds_t* shm) {
  const int tid = threadIdx.x, wid = tid >> 6, lane = tid & 63, h = lane >> 5, l31 = lane & 31;
  const bf16_t* Vs = slot(p, 5); bf16_t* U = slot(p, 4); const bf16_t* wm = (const bf16_t*)(p.ws + OFF_WM);
  __attribute__((address_space(3))) float* stats = LDSP(float, shm + 32768);
  const unsigned q4 = (lane & 15) >> 2, pp = lane & 3, blk = (lane >> 4) & 1;
  for (int w = blockIdx.x; w < T_TOK / 128; w += gridDim.x) {
    __syncthreads();
    for (int tt = 0; tt < 16; ++tt) {
      const int j = wid * 16 + tt; const u32x4* rp = (const u32x4*)(Vs + (size_t)(w * 128 + j) * DM);
      float s = 0.f, ss = 0.f;
#pragma unroll
      for (int i = 0; i < 2; ++i) { const u32x4 v = rp[lane + 64 * i];
#pragma unroll
        for (int e = 0; e < 4; ++e) { const float a = bf_lo(v[e]), bb = bf_hi(v[e]); s += a + bb; ss += a * a + bb * bb; } }
      s = wave_sum(s); ss = wave_sum(ss);
      const float mu = s * (1.0f / DM), var = fmaxf(ss * (1.0f / DM) - mu * mu, 0.f);
      if (lane == 0) { stats[2 * j] = mu; stats[2 * j + 1] = rsqrtf(var + 1e-5f); }
    }
    for (int g = 0; g < 8; ++g) {
      __syncthreads();
#pragma unroll
      for (int i = 0; i < 4; ++i) {
        const int idx = tid + 512 * i, row = idx >> 4, ch = idx & 15; const int c0 = g * 128 + ch * 8;
        const u32x4 v = *(const u32x4*)(Vs + (size_t)(w * 128 + row) * DM + c0);
        const float mu = stats[2 * row], rs = stats[2 * row + 1];
        const f32x4 g0 = *(const f32x4*)(p.ln_g + c0), g1 = *(const f32x4*)(p.ln_g + c0 + 4), b0 = *(const f32x4*)(p.ln_b + c0), b1 = *(const f32x4*)(p.ln_b + c0 + 4);
        u32x4 o;
        o.x = pk2((bf_lo(v.x) - mu) * rs * g0[0] + b0[0], (bf_hi(v.x) - mu) * rs * g0[1] + b0[1]);
        o.y = pk2((bf_lo(v.y) - mu) * rs * g0[2] + b0[2], (bf_hi(v.y) - mu) * rs * g0[3] + b0[3]);
        o.z = pk2((bf_lo(v.z) - mu) * rs * g1[0] + b1[0], (bf_hi(v.z) - mu) * rs * g1[1] + b1[1]);
        o.w = pk2((bf_lo(v.w) - mu) * rs * g1[2] + b1[2], (bf_hi(v.w) - mu) * rs * g1[3] + b1[3]);
        *LDSP(u32x4, shm + off_a(row, ch)) = o;
      }
      __syncthreads();
      const int ib = wid & 3, chalf = wid >> 2, nks = (ib < 2) ? 4 : 8;
      f32x16 acc[2];
#pragma unroll
      for (int cc = 0; cc < 2; ++cc)
#pragma unroll
        for (int i = 0; i < 16; ++i) acc[cc][i] = 0.f;
      const bf16_t* wrow = wm + ((size_t)(g * 128 + ib * 32 + l31)) * 128 + 8 * h;
      for (int ks = 0; ks < nks; ++ks) {
        const bf16x8 bfr = *(const bf16x8*)(wrow + 16 * ks);
#pragma unroll
        for (int cc = 0; cc < 2; ++cc) {
          const unsigned chb = 4 * (2 * chalf + cc) + 2 * blk + (pp >> 1);
          const bf16x8 af = tr_pair(shm + off_a(16 * ks + 8 * h + q4, chb) + 8 * (pp & 1), shm + off_a(16 * ks + 8 * h + 4 + q4, chb) + 8 * (pp & 1));
          acc[cc] = MFMA32(af, bfr, acc[cc]);
        }
      }
      const int tok = w * 128 + ib * 32 + l31; const float bias = p.sg_b[g * 128 + ib * 32 + l31];
#pragma unroll
      for (int cc = 0; cc < 2; ++cc)
#pragma unroll
        for (int g4 = 0; g4 < 4; ++g4) {
          bf16_t* up = U + (size_t)tok * DM + g * 128 + 32 * (2 * chalf + cc) + 8 * g4 + 4 * h;
          const u32x2 uu = *(const u32x2*)up; f32x4 o;
          o[0] = bf_lo(uu.x) * (acc[cc][4 * g4 + 0] + bias); o[1] = bf_hi(uu.x) * (acc[cc][4 * g4 + 1] + bias);
          o[2] = bf_lo(uu.y) * (acc[cc][4 * g4 + 2] + bias); o[3] = bf_hi(uu.y) * (acc[cc][4 * g4 + 3] + bias);
          st_bf4(up, o);
        }
    }
  }
}

DI void final_phase(const Params& p) {
  const float* ssq = (const float*)(p.ws + OFF_SSQ) + 2 * T_TOK;
  const int gt = blockIdx.x * NTHR + threadIdx.x, gn = gridDim.x * NTHR;
  for (int i = gt; i < T_TOK * DM / 4; i += gn) {
    const int row = i >> 8, c4 = (i & 255) * 4; const float rs = rsqrtf(ssq[row] * (1.0f / DM) + RMS_EPS);
    f32x4 v = *(f32x4*)(p.out + (size_t)i * 4); v = v * rs * *(const f32x4*)(p.g_final + c4); *(f32x4*)(p.out + (size_t)i * 4) = v;
  }
}

constexpr int N_PHASES = 12;
template <int PH> DI void run_phase(const Params& p, lds_t* shm) {
  float* ssq = (float*)(p.ws + OFF_SSQ);
  if (PH == 0) prep_phase(p, shm);
  else if (PH == 1) {
    g8::gemm_phase(slot(p, 0), wt(p, W_IN), T_TOK, 7168, 1024, EpiProj{p}, shm);
    g8::gemm_phase((const bf16_t*)(p.ws + OFF_MEMN), wt(p, W_XKV), 1024, 2048, 1024, EpiPlainBf16{(bf16_t*)(p.ws + OFF_KVX), 2048}, shm);
  }
  else if (PH == 2) sg_phase(p, shm);
  else if (PH == 3) diff_attn_phase(p, shm);
  else if (PH == 4) merged_phase(p, shm);
  else if (PH == 5) g8::gemm_phase(slot(p, 1), wt(p, W_OUT), T_TOK, 1024, 1024, EpiResid{p.x, p.out, slot(p, 2), ssq}, shm);
  else if (PH == 6) g8::gemm_phase(slot(p, 2), wt(p, W_XQ), T_TOK, 1024, 1024, EpiRowScale{slot(p, 3), 1024, ssq, 0.0625f * LOG2E, 0}, shm);
  else if (PH == 7) cross_attn_phase(p, shm);
  else if (PH == 8) g8::gemm_phase(slot(p, 0), wt(p, W_XO), T_TOK, 1024, 1024, EpiResid{p.out, p.out, slot(p, 1), ssq + T_TOK}, shm);
  else if (PH == 9) g8::gemm_phase(slot(p, 1), wt(p, W_FF1), T_TOK, 4096, 1024, EpiRowScale{slot(p, 2), 4096, ssq + T_TOK, 1.0f, 1}, shm);
  else if (PH == 10) g8::gemm_phase(slot(p, 2), wt(p, W_FF2), T_TOK, 1024, 4096, EpiResid{p.out, p.out, nullptr, ssq + 2 * T_TOK}, shm);
  else if (PH == 11) final_phase(p);
}

extern __shared__ __attribute__((aligned(16))) unsigned char smem_raw[];

#if !MK_COOP
template <int PH> __global__ void __launch_bounds__(NTHR) phase_kernel(Params p) { run_phase<PH>(p, (lds_t*)smem_raw); }
template <int PH> static void launch_phases(const Params& p, int grid, hipStream_t stream) {
  (void)hipFuncSetAttribute((const void*)phase_kernel<PH>, hipFuncAttributeMaxDynamicSharedMemorySize, SMEM_BYTES);
  hipLaunchKernelGGL(phase_kernel<PH>, dim3(grid), dim3(NTHR), SMEM_BYTES, stream, p);
  if constexpr (PH + 1 < N_PHASES) launch_phases<PH + 1>(p, grid, stream);
}
#else

template <int PH> DI void run_from(const Params& p, lds_t* shm, cg::grid_group& grid) {
  run_phase<PH>(p, shm);
  if constexpr (PH + 1 < N_PHASES) { grid.sync(); run_from<PH + 1>(p, shm, grid); }
}
__global__ void __launch_bounds__(NTHR) mega_kernel(Params p) {
  cg::grid_group grid = cg::this_grid();
  run_from<0>(p, (lds_t*)smem_raw, grid);
}

#endif

extern "C" void kernel_launch(void* const* d_in, const int* in_sizes, int n_in, void* d_out, int out_size, void* d_ws, size_t ws_size, hipStream_t stream) {
  Params p{};
  p.x = (const float*)d_in[0]; p.mem = (const float*)d_in[1]; p.pos = (const int*)d_in[2];
  p.g_mix = (const float*)d_in[3]; p.w_in = (const float*)d_in[4]; p.lq1 = (const float*)d_in[5]; p.lk1 = (const float*)d_in[6]; p.lq2 = (const float*)d_in[7]; p.lk2 = (const float*)d_in[8];
  p.g_subln = (const float*)d_in[9]; p.ln_g = (const float*)d_in[10]; p.ln_b = (const float*)d_in[11]; p.sg_w = (const float*)d_in[12]; p.sg_b = (const float*)d_in[13];
  p.w_ba = (const float*)d_in[14]; p.w_bs = (const float*)d_in[15]; p.w_out = (const float*)d_in[16]; p.g_xa = (const float*)d_in[17]; p.g_mem = (const float*)d_in[18];
  p.w_xq = (const float*)d_in[19]; p.w_xkv = (const float*)d_in[20]; p.w_xo = (const float*)d_in[21]; p.g_ffn = (const float*)d_in[22]; p.w_ff1 = (const float*)d_in[23]; p.w_ff2 = (const float*)d_in[24];
  p.g_final = (const float*)d_in[25]; p.out = (float*)d_out; p.ws = (unsigned char*)d_ws;
#if MK_COOP
  static int grid_blocks = 0;
  if (!grid_blocks) {
    int dev = 0, cus = 0, per_cu = 0; hipGetDevice(&dev); hipDeviceGetAttribute(&cus, hipDeviceAttributeMultiprocessorCount, dev);
    hipFuncSetAttribute((const void*)mega_kernel, hipFuncAttributeMaxDynamicSharedMemorySize, SMEM_BYTES);
    hipOccupancyMaxActiveBlocksPerMultiprocessor(&per_cu, mega_kernel, NTHR, SMEM_BYTES);
    if (per_cu < 1) per_cu = 1;
    grid_blocks = cus * per_cu;
  }
  void* args[] = {&p};
  hipError_t e = hipLaunchCooperativeKernel((const void*)mega_kernel, dim3(grid_blocks), dim3(NTHR), args, SMEM_BYTES, stream);
  if (e != hipSuccess) fprintf(stderr, "cooperative launch failed: %s (grid %d)\n", hipGetErrorString(e), grid_blocks);
#else
  launch_phases<0>(p, 256, stream);
#endif
}
```

```cpp
#include <hip/hip_runtime.h>
#include <hip/hip_cooperative_groups.h>
#include <cstdio>
#include <cstdint>
namespace cg = cooperative_groups;

#ifndef MK_COOP
#define MK_COOP 1
#endif

#define DI __device__ __forceinline__
typedef unsigned short bf16_t;
typedef short bf16x8 __attribute__((ext_vector_type(8)));
typedef short s16x4 __attribute__((ext_vector_type(4)));
typedef float f32x2 __attribute__((ext_vector_type(2)));
typedef float f32x4 __attribute__((ext_vector_type(4)));
typedef float f32x16 __attribute__((ext_vector_type(16)));
typedef unsigned u32x2 __attribute__((ext_vector_type(2)));
typedef unsigned u32x4 __attribute__((ext_vector_type(4)));
typedef __bf16 bf2_t __attribute__((ext_vector_type(2)));
typedef __attribute__((address_space(3))) unsigned char lds_t;
#define LDSP(T, p) ((__attribute__((address_space(3))) T*)(p))

constexpr int T_TOK = 32768, SEQ = 8192, DM = 1024, NTHR = 512;
constexpr float RMS_EPS = 1e-6f, LOG2E = 1.4426950408889634f;
constexpr size_t MiB = 1024 * 1024;
constexpr size_t OFF_ROPE = 0, OFF_SSQ = 2 * MiB, OFF_WM = 3 * MiB, OFF_BAR = 3 * MiB + 512 * 1024, OFF_MEMN = 4 * MiB, OFF_KVX = 6 * MiB, OFF_W = 16 * MiB, OFF_SLOT = 64 * MiB, SLOT = 64 * MiB;
constexpr size_t W_IN = 0, W_BA = 14, W_BS = 16, W_OUT = 18, W_XQ = 20, W_XKV = 22, W_XO = 26, W_FF1 = 28, W_FF2 = 36;
constexpr int SMEM_BYTES = 163840;

struct Params {
  const float *x, *mem; const int* pos;
  const float *g_mix, *w_in, *lq1, *lk1, *lq2, *lk2, *g_subln, *ln_g, *ln_b, *sg_w, *sg_b, *w_ba, *w_bs, *w_out, *g_xa, *g_mem, *w_xq, *w_xkv, *w_xo, *g_ffn, *w_ff1, *w_ff2, *g_final;
  float* out; unsigned char* ws;
};

DI int tidx() { int t = threadIdx.x; asm volatile("" : "+v"(t)); return t; }
DI unsigned pk2(float lo, float hi) { bf2_t v = __builtin_convertvector((f32x2){lo, hi}, bf2_t); return __builtin_bit_cast(unsigned, v); }
DI float bf_lo(unsigned u) { return __uint_as_float(u << 16); }
DI float bf_hi(unsigned u) { return __uint_as_float(u & 0xffff0000u); }
DI float wave_sum(float v) {
  v += __shfl_xor(v, 32); v += __shfl_xor(v, 16); v += __shfl_xor(v, 8); v += __shfl_xor(v, 4); v += __shfl_xor(v, 2); v += __shfl_xor(v, 1); return v;
}
template <class T> DI T gld(const void* base, unsigned off) { return *(const T*)((const char*)base + off); }
template <class T> DI void gst(void* base, unsigned off, T v) { *(T*)((char*)base + off) = v; }
DI bf16_t* slot(const Params& p, int i) { return (bf16_t*)(p.ws + OFF_SLOT + (size_t)i * SLOT); }
DI bf16_t* wt(const Params& p, size_t mib) { return (bf16_t*)(p.ws + OFF_W + mib * MiB); }
#define MFMA32(a, b, c) __builtin_amdgcn_mfma_f32_32x32x16_bf16((a), (b), (c), 0, 0, 0)

#ifndef GSP2
#define GSP2 true
#endif
#ifndef GALIGN
#define GALIGN true
#endif
namespace g8 {
constexpr int BM = 256, BK = 64, HALF = 128, HTB = HALF * BK * 2, NXCD = 8, WGM = 8;
typedef f32x4 Acc[2][2][4][2];
DI int lds_byte(int r, int c) { int st = (r >> 4) * 2 + (c >> 5), rr = r & 15, cc = c & 31, ob = rr * 64 + cc * 2; return st * 1024 + (ob ^ (((ob >> 9) & 1) << 5)); }
DI void stage_rc(int b, int& R, int& C) { int st = b / 1024, sb = b % 1024, swz = sb ^ (((sb >> 9) & 1) << 5); R = (st >> 1) * 16 + swz / 64; C = (st & 1) * 32 + (swz % 64) / 2; }

DI int perm32(int rho) { const int n = rho >> 4, i = rho & 15; return 8 * (i >> 2) + 4 * n + (i & 3); }
DI bool tile_coords(int L, int nM, int nN, int& pm, int& pn) {
  const int nwg = nM * nN; if (L >= nwg) return false;
  int wgid = L; { const int q = nwg / NXCD, r = nwg % NXCD, xcd = wgid % NXCD, off = wgid / NXCD; wgid = (xcd < r ? xcd * (q + 1) : r * (q + 1) + (xcd - r) * q) + off; }
  const int nig = WGM * nN, gid = wgid / nig, fm = gid * WGM, gsz = (nM - fm) < WGM ? (nM - fm) : WGM;
  pm = fm + ((wgid % nig) % gsz); pn = (wgid % nig) / gsz; return true;
}

DI void zero_acc(Acc& acc) {
#pragma unroll
  for (int a = 0; a < 2; ++a)
#pragma unroll
    for (int b = 0; b < 2; ++b)
#pragma unroll
      for (int m = 0; m < 4; ++m)
#pragma unroll
        for (int n = 0; n < 2; ++n) acc[a][b][m][n] = (f32x4){0.f, 0.f, 0.f, 0.f};
}

template <class F> DI void epi_loop(Acc& acc, int pm, int pn, int wr, int wc, int fr, int fq, F&& f) {
#pragma unroll
  for (int ai = 0; ai < 2; ++ai)
#pragma unroll
    for (int m = 0; m < 4; ++m) {
      const int row = pm * BM + ai * HALF + wr * 64 + m * 16 + fr;
#pragma unroll
      for (int bj = 0; bj < 2; ++bj) { const int col8 = pn * BM + wc * 64 + bj * 32 + fq * 8; f(row, col8, acc[ai][bj][m][0], acc[ai][bj][m][1]); }
    }
}
DI u32x4 pk8(const f32x4& a, const f32x4& b) { u32x4 w; w.x = pk2(a[0], a[1]); w.y = pk2(a[2], a[3]); w.z = pk2(b[0], b[1]); w.w = pk2(b[2], b[3]); return w; }
template <bool NT = false> DI void st_rows16(void* base, unsigned pitch_b, unsigned row0, unsigned col0, int fr, int fq, const u32x4& w0, const u32x4& w1) {
  u32x4 x;
#pragma unroll
  for (int e = 0; e < 4; ++e) x[e] = (unsigned)__builtin_amdgcn_update_dpp(0, (int)w1[e], 0x128  , 0xf, 0xf, false);
  const bool hi = fr >= 8;
  u32x4 pa, pb;
#pragma unroll
  for (int e = 0; e < 4; ++e) { pa[e] = hi ? x[e] : w0[e]; pb[e] = hi ? w0[e] : x[e]; }
  const unsigned ra = row0 + (unsigned)(fr & 7), ca = col0 + 8u * fq + (hi ? 32u : 0u), cb = col0 + 8u * fq + (hi ? 0u : 32u);
  if (NT) { __builtin_nontemporal_store(pa, (u32x4*)((char*)base + (ra * pitch_b + ca * 2u))); __builtin_nontemporal_store(pb, (u32x4*)((char*)base + ((ra + 8u) * pitch_b + cb * 2u))); }
  else { gst<u32x4>(base, ra * pitch_b + ca * 2u, pa); gst<u32x4>(base, (ra + 8u) * pitch_b + cb * 2u, pb); }
}
DI void unpk8(const u32x4& w, f32x4& a, f32x4& b) { a[0] = bf_lo(w.x); a[1] = bf_hi(w.x); a[2] = bf_lo(w.y); a[3] = bf_hi(w.y); b[0] = bf_lo(w.z); b[1] = bf_hi(w.z); b[2] = bf_lo(w.w); b[3] = bf_hi(w.w); }

template <bool SP2, bool ALIGN_EPI, bool DUAL, class Epi> DI void gemm_phase2(const bf16_t* A, const bf16_t* Bt, const bf16_t* A2, const bf16_t* Bt2, int M, int N, int K, const Epi& E, lds_t* lds) {
  const int nM = M / BM, nN = N / BM, G = gridDim.x, cb = blockIdx.x;
  const int tid = tidx(), wid = __builtin_amdgcn_readfirstlane(tid >> 6), lane = tid & 63, wr = wid >> 2, wc = wid & 3, fr = lane & 15, fq = lane >> 4;
  const int nt = K / BK;
  unsigned voffA[2], voffB[2];
#pragma unroll
  for (int i = 0; i < 2; ++i) { int R, C; stage_rc(tid * 16 + i * 8192, R, C); const int Rb = (R >> 5) * 64 + perm32(R & 31);
    voffA[i] = (unsigned)(R * K + C) * 2u; voffB[i] = (unsigned)(Rb * K + C) * 2u; }
  const size_t kstep = (size_t)(BK * 2), hstep = (size_t)HALF * K * 2, tstep = 2 * hstep, bstep = (size_t)32 * K * 2;
  const unsigned ldsw = (unsigned)wid * 1024u;
  const int aoff = lds_byte(wr * 64 + fr, fq * 8), boff = lds_byte(wc * 32 + fr, fq * 8);
#define SA(b, h) (((b) * 2 + (h)) * HTB)
#define SB(b, h) ((4 + (b) * 2 + (h)) * HTB)
#define STAGE_(bufoff, gbase, voff) do { _Pragma("unroll") for (int _i = 0; _i < 2; ++_i) \
    __builtin_amdgcn_global_load_lds((const __attribute__((address_space(1))) unsigned*)((const char*)(gbase) + voff[_i]), LDSP(unsigned, lds + (bufoff) + ldsw + _i * 8192), 16, 0, 0); } while (0)
#define STAGE(bufoff, gbase) STAGE_(bufoff, gbase, voffA)
#define STAGEB(bufoff, gbase) STAGE_(bufoff, gbase, voffB)
#define LDA(dst, b, h) do { _Pragma("unroll") for (int m = 0; m < 4; ++m) _Pragma("unroll") for (int k = 0; k < 2; ++k) dst[m][k] = *LDSP(const bf16x8, lds + SA(b, h) + aoff + m * 2048 + k * 1024); } while (0)
#define LDB(dst, b, h) do { _Pragma("unroll") for (int n = 0; n < 2; ++n) _Pragma("unroll") for (int k = 0; k < 2; ++k) dst[n][k] = *LDSP(const bf16x8, lds + SB(b, h) + boff + n * 2048 + k * 1024); } while (0)
#define MMA(ai, bj, AT, BT) do { __builtin_amdgcn_s_setprio(1); \
    _Pragma("unroll") for (int m = 0; m < 4; ++m) _Pragma("unroll") for (int n = 0; n < 2; ++n) _Pragma("unroll") for (int k = 0; k < 2; ++k) \
      acc[ai][bj][m][n] = __builtin_amdgcn_mfma_f32_16x16x32_bf16(BT[n][k], AT[m][k], acc[ai][bj][m][n], 0, 0, 0); \
    __builtin_amdgcn_s_setprio(0); } while (0)
#define WAIT_V(n) asm volatile("s_waitcnt vmcnt(" #n ")" ::: "memory")
#define WAIT_L(n) asm volatile("s_waitcnt lgkmcnt(" #n ")" ::: "memory")
#define BAR __builtin_amdgcn_s_barrier()
#define SCHED __builtin_amdgcn_sched_barrier(0)
  int pm, pn, npm = 0, npn = 0, ui = 0, pass = 0;
  if (!tile_coords(cb, nM, nN, pm, pn)) return;
  Acc acc; zero_acc(acc);
  bf16x8 At[4][2], B0[2][2], B1[2][2];
  const char* cA = (const char*)A + (size_t)pm * tstep; const char* cB = (const char*)Bt + (size_t)pn * tstep;
  if constexpr (SP2) {
    STAGEB(SB(0, 0), cB); STAGEB(SB(0, 1), cB + bstep); STAGE(SA(0, 0), cA); STAGE(SA(0, 1), cA + hstep);
    if (wr == 1) BAR;
    WAIT_V(2); BAR;
    STAGEB(SB(1, 0), cB + kstep); STAGE(SA(1, 0), cA + kstep); STAGEB(SB(1, 1), cB + bstep + kstep);
    WAIT_V(6); BAR;
  } else {
    STAGEB(SB(0, 0), cB); STAGE(SA(0, 0), cA); STAGEB(SB(0, 1), cB + bstep); STAGE(SA(0, 1), cA + hstep);
    if (wr == 1) BAR;
    WAIT_V(4); BAR;
    STAGEB(SB(1, 0), cB + kstep); STAGE(SA(1, 0), cA + kstep); STAGEB(SB(1, 1), cB + bstep + kstep);
    WAIT_V(6); BAR;
  }
  for (;;) {
    bool has_next; int npass = 0;
    if (DUAL && pass == 0) { has_next = true; npm = pm; npn = pn; npass = 1; }
    else has_next = tile_coords((ui + 1) * G + cb, nM, nN, npm, npn);
    const char* nAb = (const char*)((DUAL && npass) ? A2 : A); const char* nBb = (const char*)((DUAL && npass) ? Bt2 : Bt);
    const char* nA = has_next ? nAb + (size_t)npm * tstep : cA; const char* nB = has_next ? nBb + (size_t)npn * tstep : cB;
    for (int t = 0; t < nt; t += 2) {
      const bool last = (t == nt - 2);
      const char* a1 = cA + (size_t)(t + 1) * kstep;
      const char* a2 = last ? nA : cA + (size_t)(t + 2) * kstep; const char* b2 = last ? nB : cB + (size_t)(t + 2) * kstep;
      const char* a3 = a2 + kstep; const char* b3 = b2 + kstep;
      if constexpr (SP2) {
        LDB(B0, 0, 0); LDB(B1, 0, 1); SCHED; LDA(At, 0, 0); STAGE(SA(1, 1), a1 + hstep);
        WAIT_V(8); WAIT_L(0); BAR; MMA(0, 0, At, B0); MMA(0, 1, At, B1); BAR; SCHED;
        LDA(At, 0, 1); STAGEB(SB(0, 0), b2); STAGEB(SB(0, 1), b2 + bstep); STAGE(SA(0, 0), a2);
        WAIT_V(8); WAIT_L(0); BAR; MMA(1, 0, At, B0); MMA(1, 1, At, B1); BAR; SCHED;
        LDB(B0, 1, 0); LDB(B1, 1, 1); SCHED; LDA(At, 1, 0); STAGE(SA(0, 1), a2 + hstep);
        WAIT_V(8); WAIT_L(0); BAR; MMA(0, 0, At, B0); MMA(0, 1, At, B1); BAR; SCHED;
        LDA(At, 1, 1); STAGEB(SB(1, 0), b3); STAGEB(SB(1, 1), b3 + bstep); STAGE(SA(1, 0), a3);
        WAIT_V(8); WAIT_L(0); BAR; MMA(1, 0, At, B0); MMA(1, 1, At, B1); BAR; SCHED;
      } else {
        LDB(B0, 0, 0); SCHED; LDA(At, 0, 0); STAGE(SA(1, 1), a1 + hstep);
        WAIT_L(8); BAR; WAIT_L(0); MMA(0, 0, At, B0); BAR; SCHED;
        LDB(B1, 0, 1); STAGEB(SB(0, 0), b2);
        BAR; WAIT_L(0); MMA(0, 1, At, B1); BAR;
        LDA(At, 0, 1); STAGE(SA(0, 0), a2);
        BAR; WAIT_L(0); MMA(1, 0, At, B0); BAR; SCHED;
        STAGEB(SB(0, 1), b2 + bstep);
        WAIT_V(6); BAR; MMA(1, 1, At, B1); BAR;
        LDB(B0, 1, 0); SCHED; LDA(At, 1, 0); STAGE(SA(0, 1), a2 + hstep);
        WAIT_L(8); BAR; WAIT_L(0); MMA(0, 0, At, B0); BAR; SCHED;
        LDB(B1, 1, 1); STAGEB(SB(1, 0), b3);
        BAR; WAIT_L(0); MMA(0, 1, At, B1); BAR;
        LDA(At, 1, 1); STAGE(SA(1, 0), a3);
        BAR; WAIT_L(0); MMA(1, 0, At, B0); BAR; SCHED;
        STAGEB(SB(1, 1), b3 + bstep);
        WAIT_V(6); BAR; MMA(1, 1, At, B1); BAR;
      }
    }
    if constexpr (ALIGN_EPI) { if (wr == 0) BAR; }
    if constexpr (DUAL) { if (pass == 0) E.mid(acc, pm, pn, wr, wc, fr, fq); else E(acc, pm, pn, wr, wc, fr, fq); }
    else E(acc, pm, pn, wr, wc, fr, fq);
    if (!has_next) break;
    if (!(DUAL && pass == 0)) { zero_acc(acc); ++ui; }
    pm = npm; pn = npn; cA = nA; cB = nB; pass = npass;
    if constexpr (ALIGN_EPI) { if (wr == 1) BAR; }
  }
  WAIT_V(0);
  if constexpr (!ALIGN_EPI) { if (wr == 0) BAR; }
  BAR;
#undef SA
#undef SB
#undef STAGE
#undef STAGEB
#undef STAGE_
#undef LDA
#undef LDB
#undef MMA
}
template <bool SP2, bool ALIGN_EPI, class Epi> DI void gemm_phase(const bf16_t* A, const bf16_t* Bt, int M, int N, int K, const Epi& E, lds_t* lds) {
  gemm_phase2<SP2, ALIGN_EPI, false>(A, Bt, nullptr, nullptr, M, N, K, E, lds);
}
}

DI void st_bf4(bf16_t* p, f32x4 v) { u32x2 w; w.x = pk2(v[0], v[1]); w.y = pk2(v[2], v[3]); *(u32x2*)p = w; }

struct EpiProj {
  Params p;
  DI void operator()(g8::Acc& acc, int pm, int pn, int wr, int wc, int fr, int fq) const {
    using namespace g8;
    const int seg = pn >> 2;
    const float* rope = (const float*)(p.ws + OFF_ROPE);
    bf16_t* dst; unsigned ld; int cofs;
    if (seg < 5) { dst = slot(p, seg + 1); ld = 1024; cofs = seg * 1024; } else { dst = (bf16_t*)p.out; ld = 2048; cofs = 5 * 1024; }
    const float qs = (seg == 0) ? 0.125f * LOG2E : 1.0f;
    const float sgn = (fq == 0) ? -1.0f : 1.0f; const bool use = fq < 2;
    const unsigned col0 = (unsigned)(pn * BM + wc * 64 - cofs);
#pragma unroll
    for (int ai = 0; ai < 2; ++ai)
#pragma unroll
      for (int m = 0; m < 4; ++m) {
        const int row0 = pm * BM + ai * HALF + wr * 64 + m * 16, row = row0 + fr;
        u32x4 w[2];
#pragma unroll
        for (int bj = 0; bj < 2; ++bj) {
          f32x4 o0 = acc[ai][bj][m][0], o1 = acc[ai][bj][m][1];
          if (seg < 2) {
            if (bj == 0) {
              const f32x4 c0 = gld<f32x4>(rope, (unsigned)row * 64u), c1 = gld<f32x4>(rope, (unsigned)row * 64u + 16u), s0 = gld<f32x4>(rope, (unsigned)row * 64u + 32u) * sgn, s1 = gld<f32x4>(rope, (unsigned)row * 64u + 48u) * sgn;
              f32x4 p0, p1;
#pragma unroll
              for (int e = 0; e < 4; ++e) { p0[e] = __shfl_xor(o0[e], 16); p1[e] = __shfl_xor(o1[e], 16); }
              const f32x4 r0 = o0 * c0 + p0 * s0, r1 = o1 * c1 + p1 * s1;
#pragma unroll
              for (int e = 0; e < 4; ++e) { o0[e] = use ? r0[e] : o0[e]; o1[e] = use ? r1[e] : o1[e]; }
            }
            o0 = o0 * qs; o1 = o1 * qs;
          } else if (seg == 3 || seg == 4) {
#pragma unroll
            for (int e = 0; e < 4; ++e) {
              { const float xx = o0[e], y2 = (-2.0f * 0.7978845608028654f * LOG2E) * (xx + 0.044715f * xx * xx * xx); o0[e] = xx * __builtin_amdgcn_rcpf(1.0f + __builtin_amdgcn_exp2f(y2)); }
              { const float xx = o1[e], y2 = (-2.0f * 0.7978845608028654f * LOG2E) * (xx + 0.044715f * xx * xx * xx); o1[e] = xx * __builtin_amdgcn_rcpf(1.0f + __builtin_amdgcn_exp2f(y2)); }
            }
          } else if (seg >= 5) {
#pragma unroll
            for (int e = 0; e < 4; ++e) { o0[e] = __builtin_amdgcn_rcpf(1.0f + __builtin_amdgcn_exp2f(-LOG2E * o0[e])); o1[e] = __builtin_amdgcn_rcpf(1.0f + __builtin_amdgcn_exp2f(-LOG2E * o1[e])); }
          }
          w[bj] = pk8(o0, o1);
        }
        st_rows16<true>(dst, ld * 2u, (unsigned)row0, col0, fr, fq, w[0], w[1]);
      }
  }
};

struct EpiPlainBf16 {
  bf16_t* dst; int ld;
  DI void operator()(g8::Acc& acc, int pm, int pn, int wr, int wc, int fr, int fq) const {
    using namespace g8;
#pragma unroll
    for (int ai = 0; ai < 2; ++ai)
#pragma unroll
      for (int m = 0; m < 4; ++m)
        st_rows16(dst, (unsigned)ld * 2u, (unsigned)(pm * BM + ai * HALF + wr * 64 + m * 16), (unsigned)(pn * BM + wc * 64), fr, fq, pk8(acc[ai][0][m][0], acc[ai][0][m][1]), pk8(acc[ai][1][m][0], acc[ai][1][m][1]));
  }
};

struct EpiResid {
  const float* resf; const bf16_t* resb; float* outf; bf16_t* outb; float* ssq;
  DI void operator()(g8::Acc& acc, int pm, int pn, int wr, int wc, int fr, int fq) const {
    using namespace g8;
#pragma unroll
    for (int ai = 0; ai < 2; ++ai)
#pragma unroll
      for (int m = 0; m < 4; ++m) {
        const int row = pm * BM + ai * HALF + wr * 64 + m * 16 + fr; float s = 0.f; u32x4 wv[2];
#pragma unroll
        for (int bj = 0; bj < 2; ++bj) {
          const int col8 = pn * BM + wc * 64 + bj * 32 + fq * 8; const unsigned eo = (unsigned)row * DM + (unsigned)col8;
          f32x4 r0, r1;
          if (resf) { r0 = gld<f32x4>(resf, eo * 4u); r1 = gld<f32x4>(resf, eo * 4u + 16u); }
          else unpk8(gld<u32x4>(resb, eo * 2u), r0, r1);
          const f32x4 o0 = r0 + acc[ai][bj][m][0], o1 = r1 + acc[ai][bj][m][1];
          if (outf) { gst<f32x4>(outf, eo * 4u, o0); gst<f32x4>(outf, eo * 4u + 16u, o1); }
          wv[bj] = pk8(o0, o1);
          s += o0[0] * o0[0] + o0[1] * o0[1] + o0[2] * o0[2] + o0[3] * o0[3] + o1[0] * o1[0] + o1[1] * o1[1] + o1[2] * o1[2] + o1[3] * o1[3];
        }
        if (outb) st_rows16(outb, DM * 2u, (unsigned)(row - fr), (unsigned)(pn * BM + wc * 64), fr, fq, wv[0], wv[1]);
        s += __shfl_xor(s, 16); s += __shfl_xor(s, 32);
        if (fq == 0) atomicAdd(ssq + row, s);
        __builtin_amdgcn_sched_barrier(0);
      }
  }
};

struct EpiResidFinal {
  const bf16_t* resb; float* outf; float* ssq; unsigned* cnt; const float* g;
  DI void operator()(g8::Acc& acc, int pm, int pn, int wr, int wc, int fr, int fq) const {
    using namespace g8;
#pragma unroll
    for (int ai = 0; ai < 2; ++ai)
#pragma unroll
      for (int m = 0; m < 4; ++m) {
        const int row = pm * BM + ai * HALF + wr * 64 + m * 16 + fr; float sq = 0.f;
#pragma unroll
        for (int bj = 0; bj < 2; ++bj) {
          const int col8 = pn * BM + wc * 64 + bj * 32 + fq * 8; const unsigned eo = (unsigned)row * DM + (unsigned)col8;
          f32x4 r0, r1; unpk8(gld<u32x4>(resb, eo * 2u), r0, r1);
          acc[ai][bj][m][0] = acc[ai][bj][m][0] + r0; acc[ai][bj][m][1] = acc[ai][bj][m][1] + r1;
          const f32x4 o0 = acc[ai][bj][m][0], o1 = acc[ai][bj][m][1];
          sq += o0[0] * o0[0] + o0[1] * o0[1] + o0[2] * o0[2] + o0[3] * o0[3] + o1[0] * o1[0] + o1[1] * o1[1] + o1[2] * o1[2] + o1[3] * o1[3];
        }
        sq += __shfl_xor(sq, 16); sq += __shfl_xor(sq, 32);
        if (fq == 0) atomicAdd(ssq + row, sq);
      }
    asm volatile("s_waitcnt vmcnt(0)" ::: "memory");
    __syncthreads();
    if (threadIdx.x == 0) {
      __hip_atomic_fetch_add(cnt + pm, 1u, __ATOMIC_RELAXED, __HIP_MEMORY_SCOPE_AGENT);
      unsigned sp = 0;
      while (__hip_atomic_load(cnt + pm, __ATOMIC_RELAXED, __HIP_MEMORY_SCOPE_AGENT) < 4u) { __builtin_amdgcn_s_sleep(1); if (++sp > (1u << 22)) break; }
    }
    __syncthreads();
#pragma unroll
    for (int ai = 0; ai < 2; ++ai)
#pragma unroll
      for (int m = 0; m < 4; ++m) {
        const int row = pm * BM + ai * HALF + wr * 64 + m * 16 + fr;
        const float rs = rsqrtf(__hip_atomic_load(ssq + row, __ATOMIC_RELAXED, __HIP_MEMORY_SCOPE_AGENT) * (1.0f / DM) + RMS_EPS);
#pragma unroll
        for (int bj = 0; bj < 2; ++bj) {
          const int col8 = pn * BM + wc * 64 + bj * 32 + fq * 8; const unsigned eo = (unsigned)row * DM + (unsigned)col8;
          gst<f32x4>(outf, eo * 4u, acc[ai][bj][m][0] * rs * gld<f32x4>(g, (unsigned)col8 * 4u));
          gst<f32x4>(outf, eo * 4u + 16u, acc[ai][bj][m][1] * rs * gld<f32x4>(g, (unsigned)col8 * 4u + 16u));
        }
      }
  }
};

struct EpiRowScale {
  bf16_t* dst; int ld; const float* ssq; float sc; int act;
  DI void operator()(g8::Acc& acc, int pm, int pn, int wr, int wc, int fr, int fq) const {
    using namespace g8;
#pragma unroll
    for (int ai = 0; ai < 2; ++ai)
#pragma unroll
      for (int m = 0; m < 4; ++m) {
        const int row = pm * BM + ai * HALF + wr * 64 + m * 16 + fr; const float rs = rsqrtf(ssq[row] * (1.0f / DM) + RMS_EPS) * sc;
        u32x4 wv[2];
#pragma unroll
        for (int bj = 0; bj < 2; ++bj) {
          f32x4 o0 = acc[ai][bj][m][0] * rs, o1 = acc[ai][bj][m][1] * rs;
          if (act) {
#pragma unroll
            for (int e = 0; e < 4; ++e) { const float a = fmaxf(o0[e], 0.f), b = fmaxf(o1[e], 0.f); o0[e] = a * a; o1[e] = b * b; } }
          wv[bj] = pk8(o0, o1);
        }
        st_rows16(dst, (unsigned)ld * 2u, (unsigned)(row - fr), (unsigned)(pn * BM + wc * 64), fr, fq, wv[0], wv[1]);
        __builtin_amdgcn_sched_barrier(0);
      }
  }
};

struct EpiGateDual {
  bf16_t* dst; const bf16_t* gates;
  DI void mid(g8::Acc& acc, int pm, int pn, int wr, int wc, int fr, int fq) const {
    using namespace g8;
#pragma unroll
    for (int ai = 0; ai < 2; ++ai)
#pragma unroll
      for (int m = 0; m < 4; ++m) {
        const int row = pm * BM + ai * HALF + wr * 64 + m * 16 + fr;
#pragma unroll
        for (int bj = 0; bj < 2; ++bj) {
          const int col8 = pn * BM + wc * 64 + bj * 32 + fq * 8; const unsigned go = ((unsigned)row * 2048u + (unsigned)col8) * 2u;
          f32x4 a0, a1, s0, s1; unpk8(gld<u32x4>(gates, go), a0, a1); unpk8(gld<u32x4>(gates, go + 2048u), s0, s1);
#pragma unroll
          for (int e = 0; e < 4; ++e) { acc[ai][bj][m][0][e] *= a0[e] * __builtin_amdgcn_rcpf(fmaxf(s0[e], 1e-30f)); acc[ai][bj][m][1][e] *= a1[e] * __builtin_amdgcn_rcpf(fmaxf(s1[e], 1e-30f)); }
        }
        __builtin_amdgcn_sched_barrier(0);
      }
  }
  DI void operator()(g8::Acc& acc, int pm, int pn, int wr, int wc, int fr, int fq) const {
    using namespace g8;
#pragma unroll
    for (int ai = 0; ai < 2; ++ai)
#pragma unroll
      for (int m = 0; m < 4; ++m) {
        const int row0 = pm * BM + ai * HALF + wr * 64 + m * 16, row = row0 + fr; u32x4 wv[2];
#pragma unroll
        for (int bj = 0; bj < 2; ++bj) {
          const int col8 = pn * BM + wc * 64 + bj * 32 + fq * 8; const unsigned go = ((unsigned)row * 2048u + (unsigned)(1024 + col8)) * 2u;
          f32x4 s0, s1; unpk8(gld<u32x4>(gates, go), s0, s1);
#pragma unroll
          for (int e = 0; e < 4; ++e) { s0[e] = fmaxf(s0[e], 1e-30f); s1[e] = fmaxf(s1[e], 1e-30f); }
          wv[bj] = pk8(acc[ai][bj][m][0] * s0, acc[ai][bj][m][1] * s1);
        }
        st_rows16(dst, DM * 2u, (unsigned)row0, (unsigned)(pn * BM + wc * 64), fr, fq, wv[0], wv[1]);
      }
  }
};
DI void merged_phase(const Params& p, lds_t* shm) {
  g8::gemm_phase2<GSP2, GALIGN, true>(slot(p, 0), wt(p, W_BA), slot(p, 4), wt(p, W_BS), T_TOK, DM, DM, EpiGateDual{slot(p, 1), (const bf16_t*)p.out}, shm);
}

DI void wt_transpose(const float* W, bf16_t* Wt, const float* gain, int K, int N, lds_t* shm) {
  const int tk = K / 64, tn = N / 64, tid = tidx();
  __attribute__((address_space(3))) float* tile = LDSP(float, shm);
  for (int t = blockIdx.x; t < tk * tn; t += gridDim.x) {
    const int k0 = (t / tn) * 64, n0 = (t % tn) * 64;
    const int r = tid >> 4, c4 = (tid & 15) * 4;
#pragma unroll
    for (int i = 0; i < 2; ++i) {
      const int kk = r + 32 * i; f32x4 v = *(const f32x4*)(W + (size_t)(k0 + kk) * N + n0 + c4);
      if (gain) v = v * gain[k0 + kk];
      tile[kk * 65 + c4 + 0] = v[0]; tile[kk * 65 + c4 + 1] = v[1]; tile[kk * 65 + c4 + 2] = v[2]; tile[kk * 65 + c4 + 3] = v[3];
    }
    __syncthreads();
    const int nn = tid >> 3, k8 = (tid & 7) * 8;
    u32x4 w;
    w.x = pk2(tile[(k8 + 0) * 65 + nn], tile[(k8 + 1) * 65 + nn]); w.y = pk2(tile[(k8 + 2) * 65 + nn], tile[(k8 + 3) * 65 + nn]);
    w.z = pk2(tile[(k8 + 4) * 65 + nn], tile[(k8 + 5) * 65 + nn]); w.w = pk2(tile[(k8 + 6) * 65 + nn], tile[(k8 + 7) * 65 + nn]);
    *(u32x4*)(Wt + (size_t)(n0 + nn) * K + k0 + k8) = w;
    __syncthreads();
  }
}

DI void rms_rows(const float* X, const float* g, bf16_t* out, int nrows) {
  const int wid = tidx() >> 6, lane = tidx() & 63; const int stride = gridDim.x * 8;
  for (int r = blockIdx.x * 8 + wid; r < nrows; r += 2 * stride) {
    const int r2 = r + stride; const bool has2 = r2 < nrows;
    const f32x4* xa = (const f32x4*)(X + (size_t)r * DM); const f32x4* xb = (const f32x4*)(X + (size_t)(has2 ? r2 : r) * DM);
    f32x4 va[4], vb[4]; float sa = 0.f, sb = 0.f;
#pragma unroll
    for (int i = 0; i < 4; ++i) { va[i] = xa[lane + 64 * i]; vb[i] = xb[lane + 64 * i]; }
#pragma unroll
    for (int i = 0; i < 4; ++i) { sa += va[i][0] * va[i][0] + va[i][1] * va[i][1] + va[i][2] * va[i][2] + va[i][3] * va[i][3]; sb += vb[i][0] * vb[i][0] + vb[i][1] * vb[i][1] + vb[i][2] * vb[i][2] + vb[i][3] * vb[i][3]; }
    sa = wave_sum(sa); sb = wave_sum(sb);
    const float ra = rsqrtf(sa * (1.0f / DM) + RMS_EPS), rb = rsqrtf(sb * (1.0f / DM) + RMS_EPS);
#pragma unroll
    for (int i = 0; i < 4; ++i) { const f32x4 gg = ((const f32x4*)g)[lane + 64 * i];
      st_bf4(out + (size_t)r * DM + (lane + 64 * i) * 4, va[i] * ra * gg);
      if (has2) st_bf4(out + (size_t)r2 * DM + (lane + 64 * i) * 4, vb[i] * rb * gg); }
  }
}

DI void prep_phase(const Params& p, lds_t* shm) {
  const int gt = blockIdx.x * NTHR + tidx(), gn = gridDim.x * NTHR;
  float* rope = (float*)(p.ws + OFF_ROPE);
  for (int i = gt; i < T_TOK * 8; i += gn) {
    const int t = i >> 3, f = i & 7; const float inv = (float)exp2(-(double)f * 0.125 * 18.931568569324174  );
    const float ang = (float)p.pos[t] * inv; float s, c; sincosf(ang, &s, &c); rope[t * 16 + f] = c; rope[t * 16 + 8 + f] = s;
  }
  float* ssq = (float*)(p.ws + OFF_SSQ);
  for (int i = gt; i < 3 * T_TOK; i += gn) ssq[i] = 0.f;
  bf16_t* wm = (bf16_t*)(p.ws + OFF_WM);
  for (int i = gt; i < 8 * 128 * 128 / 2; i += gn) {
    const int e = i * 2, ii = (e >> 7) & 127, j = e & 127; const f32x2 w = *(const f32x2*)(p.sg_w + e);
    const bool ok = (j >> 6) <= (ii >> 6); ((unsigned*)wm)[i] = ok ? pk2(w[0], w[1]) : 0u;
  }
  rms_rows(p.x, p.g_mix, slot(p, 0), T_TOK);
  rms_rows(p.mem, p.g_mem, (bf16_t*)(p.ws + OFF_MEMN), 1024);
  wt_transpose(p.w_in, wt(p, W_IN), nullptr, 1024, 7168, shm);
  wt_transpose(p.w_ba, wt(p, W_BA), nullptr, 1024, 1024, shm);
  wt_transpose(p.w_bs, wt(p, W_BS), nullptr, 1024, 1024, shm);
  wt_transpose(p.w_out, wt(p, W_OUT), nullptr, 1024, 1024, shm);
  wt_transpose(p.w_xq, wt(p, W_XQ), p.g_xa, 1024, 1024, shm);
  wt_transpose(p.w_xkv, wt(p, W_XKV), nullptr, 1024, 2048, shm);
  wt_transpose(p.w_xo, wt(p, W_XO), nullptr, 1024, 1024, shm);
  wt_transpose(p.w_ff1, wt(p, W_FF1), p.g_ffn, 1024, 4096, shm);
  wt_transpose(p.w_ff2, wt(p, W_FF2), nullptr, 4096, 1024, shm);
}

DI unsigned off_a(unsigned row, unsigned ch) { return 2048u * (row >> 3) + 512u * (ch >> 2) + 64u * (row & 7) + 16u * ((ch & 3) ^ ((row >> 2) & 3)); }
DI void inv_off_a(unsigned L, unsigned& row, unsigned& ch) {
  const unsigned o = L * 16u, b8 = o >> 11, rem = o & 2047u, chq = rem >> 9, rem2 = rem & 511u, r7 = rem2 >> 6, cx = (rem2 & 63u) >> 4;
  row = b8 * 8 + r7; ch = chq * 4 + (cx ^ ((row >> 2) & 3));
}
DI bf16x8 tr_pair(lds_t* a0, lds_t* a1) {
  const s16x4 lo = __builtin_amdgcn_ds_read_tr16_b64_v4i16(LDSP(s16x4, a0)), hi = __builtin_amdgcn_ds_read_tr16_b64_v4i16(LDSP(s16x4, a1));
  return __builtin_shufflevector(lo, hi, 0, 1, 2, 3, 4, 5, 6, 7);
}

DI void glds16(const void* base, unsigned off, lds_t* dst) {
  __builtin_amdgcn_global_load_lds((const __attribute__((address_space(1))) unsigned*)((const char*)base + off), LDSP(unsigned, dst), 16, 0, 0);
}

DI void dattn_unit2(const bf16_t* __restrict__ Qg, const bf16_t* __restrict__ Kg, const bf16_t* __restrict__ Vg, bf16_t* __restrict__ Og,
                    int ntiles, int wave_tiles, float lam, const float* __restrict__ gsub, lds_t* shm) {
  constexpr int NC = 4, LD = DM;
  constexpr unsigned VRING = 3 * 16384;
  const int tid = tidx(), lane = tid & 63, h = lane >> 5, l31 = lane & 31, wid = __builtin_amdgcn_readfirstlane(tid >> 6), grp = wid >> 2;
  unsigned soff[2];
#pragma unroll
  for (int i = 0; i < 2; ++i) { unsigned r, c; inv_off_a(tid + 512 * i, r, c); soff[i] = (r * (unsigned)LD + c * 8u) * 2u; }
  constexpr unsigned tstep = 64u * LD * 2u;
  const int last_tile = ntiles - 1;
  auto issueK = [&](int kt, int slot) __attribute__((always_inline)) {
    const int t = kt < last_tile ? kt : last_tile; lds_t* base = shm + slot * 16384 + wid * 1024; const char* kb = (const char*)Kg + (size_t)t * tstep;
    glds16(kb, soff[0], base); glds16(kb, soff[1], base + 8192);
  };
  auto issueV = [&](int kt, int slot) __attribute__((always_inline)) {
    const int t = kt < last_tile ? kt : last_tile; lds_t* base = shm + VRING + slot * 16384 + wid * 1024; const char* vb = (const char*)Vg + (size_t)t * tstep;
    glds16(vb, soff[0], base); glds16(vb, soff[1], base + 8192);
  };
#define WAIT_V(n) asm volatile("s_waitcnt vmcnt(" #n ")" ::: "memory")
#define BAR do { __builtin_amdgcn_sched_barrier(0); __builtin_amdgcn_s_barrier(); asm volatile("" ::: "memory"); __builtin_amdgcn_sched_barrier(0); } while (0)
  __syncthreads();
  lds_t* Qst = shm + 6 * 16384 + wid * 8192;
#pragma unroll
  for (int i = 0; i < 8; ++i) { unsigned r, c; inv_off_a(lane + 64 * i, r, c); glds16(Qg, (r * (unsigned)LD + c * 8u) * 2u, Qst + i * 1024); }
  issueK(0, 0); issueV(0, 0); issueK(1, 1); issueV(1, 1);
  f32x16 O[2][NC];
#pragma unroll
  for (int m = 0; m < 2; ++m)
#pragma unroll
    for (int c = 0; c < NC; ++c)
#pragma unroll
      for (int i = 0; i < 16; ++i) O[m][c][i] = 0.f;
  float mrun[2] = {-INFINITY, -INFINITY}, lrun[2] = {0.f, 0.f};
  const unsigned q4 = (lane & 15) >> 2, pp = lane & 3, blk = (lane >> 4) & 1;
  const unsigned xk = (l31 >> 2) & 3, kbase = 2048u * (l31 >> 3) + 64u * (l31 & 7);
  const unsigned ka0 = kbase + 16u * ((unsigned)h ^ xk), ka2 = kbase + 16u * ((2u + h) ^ xk);
  const unsigned vrow = 64u * (4u * h + q4), cl = 2u * blk + (pp >> 1);
  const unsigned va0 = VRING + vrow + 16u * (cl ^ (unsigned)h) + 8u * (pp & 1), va1 = VRING + vrow + 16u * (cl ^ ((unsigned)h ^ 2u)) + 8u * (pp & 1);
  WAIT_V(6); BAR;
  if (grp == 1) { WAIT_V(4); BAR; }
  if (grp == 1) __builtin_amdgcn_s_setprio(1);
  int slot = 0;
  for (int kt = 0; kt < ntiles; ++kt) {
    const int slot2 = slot >= 1 ? slot - 1 : 2;
    issueK(kt + 2, slot2);
    const float msk = (kt < wave_tiles) ? 0.f : -INFINITY;
    const unsigned so = slot * 16384;
    lds_t* K0 = shm + (so + ka0); lds_t* K2 = shm + (so + ka2);
    bf16x8 P[2][2][2]; float alpha[2]; bool resc[2];
#pragma unroll
    for (int m = 0; m < 2; ++m) {
      f32x16 s[2];
#pragma unroll
      for (int kb = 0; kb < 2; ++kb)
#pragma unroll
        for (int i = 0; i < 16; ++i) s[kb][i] = 0.f;
#pragma unroll
      for (int ss = 0; ss < 4; ++ss) {
        const bf16x8 qv = *LDSP(const bf16x8, Qst + ((ss & 1) ? ka2 : ka0) + 512 * (ss >> 1) + 1024 * m);
#pragma unroll
        for (int kb = 0; kb < 2; ++kb) {
          const bf16x8 kf = *LDSP(const bf16x8, ((ss & 1) ? K2 : K0) + kb * 8192 + 512 * (ss >> 1) + 1024 * m);
          s[kb] = MFMA32(kf, qv, s[kb]);
        }
      }
      float mx = s[0][0];
#pragma unroll
      for (int i = 1; i < 16; ++i) mx = fmaxf(mx, s[0][i]);
#pragma unroll
      for (int i = 0; i < 16; ++i) mx = fmaxf(mx, s[1][i]);
      { const auto sw = __builtin_amdgcn_permlane32_swap(__float_as_uint(mx), __float_as_uint(mx), false, false); mx = fmaxf(__uint_as_float(sw[0]), __uint_as_float(sw[1])) + msk; }
      resc[m] = __builtin_amdgcn_ballot_w64(mx > mrun[m] + 8.0f) != 0;
      alpha[m] = 1.0f;
      if (resc[m]) { const float mnew = fmaxf(mrun[m], mx); alpha[m] = __builtin_amdgcn_exp2f(mrun[m] - mnew); mrun[m] = mnew; lrun[m] *= alpha[m]; }
      const float msub = mrun[m] - msk;
      float rs = 0.f;
#pragma unroll
      for (int kb = 0; kb < 2; ++kb)
#pragma unroll
        for (int s2 = 0; s2 < 2; ++s2) {
          float e[8];
#pragma unroll
          for (int j = 0; j < 8; ++j) { e[j] = __builtin_amdgcn_exp2f(s[kb][8 * s2 + j] - msub); rs += e[j]; }
          u32x4 w; w.x = pk2(e[0], e[1]); w.y = pk2(e[2], e[3]); w.z = pk2(e[4], e[5]); w.w = pk2(e[6], e[7]);
          P[m][kb][s2] = __builtin_bit_cast(bf16x8, w);
          __builtin_amdgcn_sched_barrier(0);
        }
      lrun[m] += rs;
      __builtin_amdgcn_sched_barrier(0);
    }
    __builtin_amdgcn_sched_barrier(0);
    WAIT_V(4); BAR;
    issueV(kt + 2, slot2);
    lds_t* V0 = shm + (so + va0); lds_t* V1 = shm + (so + va1);
#pragma unroll
    for (int m = 0; m < 2; ++m)
      if (resc[m]) {
#pragma unroll
        for (int c = 0; c < NC; ++c) O[m][c] = O[m][c] * alpha[m];
      }
#pragma unroll
    for (int ks = 0; ks < 4; ++ks) {
      bf16x8 vf[NC];
#pragma unroll
      for (int c = 0; c < NC; ++c) { const int vo = 512 * c + 4096 * ks; vf[c] = tr_pair(V0 + vo, V1 + vo + 2048); }
#pragma unroll
      for (int c = 0; c < NC; ++c) { O[0][c] = MFMA32(vf[c], P[0][ks >> 1][ks & 1], O[0][c]); O[1][c] = MFMA32(vf[c], P[1][ks >> 1][ks & 1], O[1][c]); }
    }
    __builtin_amdgcn_sched_barrier(0);
    WAIT_V(4); BAR;
    slot = slot == 2 ? 0 : slot + 1;
  }
  if (grp == 0) BAR;
  __builtin_amdgcn_s_setprio(0);
#undef WAIT_V
#undef BAR
  const float l0 = lrun[0] + __shfl_xor(lrun[0], 32), l1 = lrun[1] + __shfl_xor(lrun[1], 32);
  const float i0 = 1.0f / l0, i1 = lam / l1;
  float ssq = 0.f;
#pragma unroll
  for (int c = 0; c < NC; ++c)
#pragma unroll
    for (int i = 0; i < 16; ++i) { const float a = O[0][c][i] * i0 - O[1][c][i] * i1; O[0][c][i] = a; ssq += a * a; }
  ssq += __shfl_xor(ssq, 32);
  const float inv = rsqrtf(ssq * (1.0f / 128.0f) + RMS_EPS) * 0.8f;
  const int lane_f = tidx() & 63, h_f = lane_f >> 5;
  const unsigned ooff = ((unsigned)(lane_f & 31) * (unsigned)LD + 4u * h_f) * 2u;
#pragma unroll
  for (int c = 0; c < NC; ++c)
#pragma unroll
    for (int g4 = 0; g4 < 4; ++g4) {
      const int dv0 = 32 * c + 8 * g4; f32x4 o;
#pragma unroll
      for (int e = 0; e < 4; ++e) o[e] = O[0][c][4 * g4 + e] * inv;
      o = o * gld<f32x4>(gsub + dv0, 16u * h_f);
      u32x2 w; w.x = pk2(o[0], o[1]); w.y = pk2(o[2], o[3]);
      gst<u32x2>(Og + dv0, ooff, w);
    }
}

DI void diff_attn_phase(const Params& p, lds_t* shm) {
  const int wid = __builtin_amdgcn_readfirstlane(tidx() >> 6), lane = tidx() & 63;
  const float d1 = wave_sum(p.lq1[lane] * p.lk1[lane]), d2 = wave_sum(p.lq2[lane] * p.lk2[lane]);
  const float lam = __uint_as_float(__builtin_amdgcn_readfirstlane(__float_as_uint(expf(d1) - expf(d2) + 0.2f)));
  const bf16_t *Q = slot(p, 1), *K = slot(p, 2), *V = slot(p, 3); bf16_t* A = slot(p, 0);
  const int nit = (gridDim.x == 256) ? 2 : (512 + gridDim.x - 1) / gridDim.x;
  for (int it = 0; it < nit; ++it) {
    int pi;
    if (gridDim.x == 256) { const int x = blockIdx.x & 7, j = blockIdx.x >> 3, t = j + 32 * it; pi = (4 * x + (t >> 4)) * 16 + (t & 15); }
    else { pi = blockIdx.x + it * gridDim.x; if (pi >= 512) break; }
    const int bh = pi >> 4, pp = pi & 15, b = bh >> 3, hd = bh & 7;
    for (int e = 0; e < 2; ++e) {
      const int qb = e ? pp : 31 - pp; const size_t r0 = (size_t)b * SEQ + qb * 256 + wid * 32;
      dattn_unit2(Q + r0 * DM + hd * 128, K + (size_t)b * SEQ * DM + hd * 128, V + (size_t)b * SEQ * DM + hd * 128, A + r0 * DM + hd * 128,
                  qb * 4 + 4, qb * 4 + (wid >> 1) + 1, lam, p.g_subln, shm);
    }
  }
}

DI void xattn_unit(const bf16_t* __restrict__ Qg, const bf16_t* __restrict__ Kg, const bf16_t* __restrict__ Vg, bf16_t* __restrict__ Og, lds_t* shm) {
  constexpr int LDQ = DM, LDKV = 2048, NC = 8;
  const int tid = tidx(), lane = tid & 63, h = lane >> 5, l31 = lane & 31, wid = __builtin_amdgcn_readfirstlane(tid >> 6);
  unsigned soff[2];
#pragma unroll
  for (int i = 0; i < 2; ++i) { unsigned r, c; inv_off_a(tid + 512 * i, r, c); soff[i] = (r * (unsigned)LDKV + c * 8u) * 2u; }
  constexpr unsigned tstep = 64u * LDKV * 2u;
  auto issue_tile = [&](const bf16_t* src, int t, unsigned lds_base) __attribute__((always_inline)) {
    const char* sb = (const char*)src + (size_t)t * tstep; lds_t* base = shm + lds_base + wid * 1024;
#pragma unroll
    for (int im = 0; im < 2; ++im) { glds16(sb + im * 256, soff[0], base + im * 16384); glds16(sb + im * 256, soff[1], base + im * 16384 + 8192); }
  };
  __syncthreads();
#pragma unroll
  for (int t = 0; t < 4; ++t) issue_tile(Kg, t, t * 32768);
  issue_tile(Vg, 0, 131072);
  const unsigned q4 = (lane & 15) >> 2, pp = lane & 3, blk = (lane >> 4) & 1;
  const unsigned xk = (l31 >> 2) & 3, kbase = 2048u * (l31 >> 3) + 64u * (l31 & 7);
  const unsigned ka0 = kbase + 16u * ((unsigned)h ^ xk), ka2 = kbase + 16u * ((2u + h) ^ xk);
  const unsigned vrow = 64u * (4u * h + q4), cl = 2u * blk + (pp >> 1);
  const unsigned va0 = vrow + 16u * (cl ^ (unsigned)h) + 8u * (pp & 1), va1 = vrow + 16u * (cl ^ ((unsigned)h ^ 2u)) + 8u * (pp & 1);
  const unsigned qoff = ((unsigned)l31 * (unsigned)LDQ + 8u * h) * 2u;
  f32x16 S[4][2];
#pragma unroll
  for (int t = 0; t < 4; ++t)
#pragma unroll
    for (int kb = 0; kb < 2; ++kb)
#pragma unroll
      for (int i = 0; i < 16; ++i) S[t][kb][i] = 0.f;
  asm volatile("s_waitcnt vmcnt(0)" ::: "memory");
  __syncthreads();
  __builtin_amdgcn_sched_barrier(0);
#pragma unroll
  for (int ss = 0; ss < 16; ++ss) {
    const int cgl = 2 * ss, img = cgl >> 4;
    const bf16x8 qv = gld<bf16x8>(Qg + 16 * ss, qoff);
#pragma unroll
    for (int t = 0; t < 4; ++t)
#pragma unroll
      for (int kb = 0; kb < 2; ++kb) {
        const bf16x8 kf = *LDSP(const bf16x8, shm + t * 32768 + img * 16384 + kb * 8192 + 512 * ((cgl & 15) >> 2) + ((cgl & 2) ? ka2 : ka0));
        S[t][kb] = MFMA32(kf, qv, S[t][kb]);
      }
  }
  float mx = S[0][0][0];
#pragma unroll
  for (int t = 0; t < 4; ++t)
#pragma unroll
    for (int kb = 0; kb < 2; ++kb)
#pragma unroll
      for (int i = 0; i < 16; ++i) mx = fmaxf(mx, S[t][kb][i]);
  { const auto sw = __builtin_amdgcn_permlane32_swap(__float_as_uint(mx), __float_as_uint(mx), false, false); mx = fmaxf(__uint_as_float(sw[0]), __uint_as_float(sw[1])); }
  float rs = 0.f;
  bf16x8 P[4][2][2];
#pragma unroll
  for (int t = 0; t < 4; ++t)
#pragma unroll
    for (int kb = 0; kb < 2; ++kb)
#pragma unroll
      for (int s2 = 0; s2 < 2; ++s2) {
        float e[8];
#pragma unroll
        for (int j = 0; j < 8; ++j) { e[j] = __builtin_amdgcn_exp2f(S[t][kb][8 * s2 + j] - mx); rs += e[j]; }
        u32x4 w; w.x = pk2(e[0], e[1]); w.y = pk2(e[2], e[3]); w.z = pk2(e[4], e[5]); w.w = pk2(e[6], e[7]);
        P[t][kb][s2] = __builtin_bit_cast(bf16x8, w);
      }
  const float l = rs + __shfl_xor(rs, 32);
  __builtin_amdgcn_sched_barrier(0);
  __syncthreads();
  __builtin_amdgcn_sched_barrier(0);
#pragma unroll
  for (int t = 1; t < 4; ++t) issue_tile(Vg, t, t * 32768);
  f32x16 O[NC];
#pragma unroll
  for (int c = 0; c < NC; ++c)
#pragma unroll
    for (int i = 0; i < 16; ++i) O[c][i] = 0.f;
#pragma unroll
  for (int t = 0; t < 4; ++t) {
    if (t == 1) { __builtin_amdgcn_sched_barrier(0); asm volatile("s_waitcnt vmcnt(0)" ::: "memory"); __syncthreads(); __builtin_amdgcn_sched_barrier(0); }
    const unsigned vbase = (t == 0) ? 131072u : (unsigned)t * 32768u;
#pragma unroll
    for (int ks = 0; ks < 4; ++ks)
#pragma unroll
      for (int c = 0; c < NC; ++c) {
        const unsigned vo = vbase + (c >> 2) * 16384 + 512 * (c & 3) + 4096 * ks;
        const bf16x8 vf = tr_pair(shm + vo + va0, shm + vo + 2048 + va1);
        O[c] = MFMA32(vf, P[t][ks >> 1][ks & 1], O[c]);
      }
  }
  const float inv = 1.0f / l;
  const unsigned ooff = ((unsigned)l31 * (unsigned)LDQ + 4u * h) * 2u;
#pragma unroll
  for (int c = 0; c < NC; ++c)
#pragma unroll
    for (int g4 = 0; g4 < 4; ++g4) {
      u32x2 w; w.x = pk2(O[c][4 * g4 + 0] * inv, O[c][4 * g4 + 1] * inv); w.y = pk2(O[c][4 * g4 + 2] * inv, O[c][4 * g4 + 3] * inv);
      gst<u32x2>(Og + 32 * c + 8 * g4, ooff, w);
    }
}

DI void cross_attn_own_tiles(const Params& p, lds_t* shm) {
  const int wid = __builtin_amdgcn_readfirstlane(tidx() >> 6);
  const bf16_t* Q = slot(p, 3); const bf16_t* KV = (const bf16_t*)(p.ws + OFF_KVX); bf16_t* O = slot(p, 0);
  for (int i = 0;; ++i) {
    int pm, pn; if (!g8::tile_coords(i * (int)gridDim.x + (int)blockIdx.x, T_TOK / 256, 4, pm, pn)) break;
    const int b = pm >> 5, hd = pn; const size_t r0 = (size_t)pm * 256 + wid * 32;
    xattn_unit(Q + r0 * DM + hd * 256, KV + (size_t)b * 256 * 2048 + hd * 256, KV + (size_t)b * 256 * 2048 + 1024 + hd * 256, O + r0 * DM + hd * 256, shm);
  }
}

DI void cross_attn_phase(const Params& p, lds_t* shm) {
  const int wid = __builtin_amdgcn_readfirstlane(tidx() >> 6);
  const bf16_t* Q = slot(p, 3); const bf16_t* KV = (const bf16_t*)(p.ws + OFF_KVX); bf16_t* O = slot(p, 0);
  for (int u = blockIdx.x; u < 512; u += gridDim.x) {
    const int bh = u >> 5, qb = u & 31, b = bh >> 2, hd = bh & 3; const size_t r0 = (size_t)b * SEQ + qb * 256 + wid * 32;
    xattn_unit(Q + r0 * DM + hd * 256, KV + (size_t)b * 256 * 2048 + hd * 256, KV + (size_t)b * 256 * 2048 + 1024 + hd * 256, O + r0 * DM + hd * 256, shm);
  }
}

DI void sg_phase(const Params& p, lds_t* shm) {
  const int tid = tidx(), wid = tid >> 6, lane = tid & 63, h = lane >> 5, l31 = lane & 31;
  const bf16_t* Vs = slot(p, 5); bf16_t* U = slot(p, 4); const bf16_t* wm = (const bf16_t*)(p.ws + OFF_WM);
  __attribute__((address_space(3))) float* stats = LDSP(float, shm + 32768);
  const unsigned q4 = (lane & 15) >> 2, pp = lane & 3, blk = (lane >> 4) & 1;
  for (int w = blockIdx.x; w < T_TOK / 128; w += gridDim.x) {
    __syncthreads();
    for (int t4 = 0; t4 < 16; t4 += 4) {
      u32x4 rv[4][2];
#pragma unroll
      for (int q = 0; q < 4; ++q) { const u32x4* rp = (const u32x4*)(Vs + (size_t)(w * 128 + wid * 16 + t4 + q) * DM); rv[q][0] = rp[lane]; rv[q][1] = rp[lane + 64]; }
      float sm[4], sq[4];
#pragma unroll
      for (int q = 0; q < 4; ++q) { float a0 = 0.f, a1 = 0.f;
#pragma unroll
        for (int i = 0; i < 2; ++i)
#pragma unroll
          for (int e = 0; e < 4; ++e) { const float a = bf_lo(rv[q][i][e]), bb = bf_hi(rv[q][i][e]); a0 += a + bb; a1 += a * a + bb * bb; }
        sm[q] = a0; sq[q] = a1; }
#pragma unroll
      for (int q = 0; q < 4; ++q) { sm[q] = wave_sum(sm[q]); sq[q] = wave_sum(sq[q]); }
#pragma unroll
      for (int q = 0; q < 4; ++q) { const int j = wid * 16 + t4 + q; const float mu = sm[q] * (1.0f / DM), var = fmaxf(sq[q] * (1.0f / DM) - mu * mu, 0.f);
        if (lane == 0) { stats[2 * j] = mu; stats[2 * j + 1] = rsqrtf(var + 1e-5f); } }
    }
    u32x4 raw[4];
#pragma unroll
    for (int i = 0; i < 4; ++i) { const int idx = tid + 512 * i, row = idx >> 4, ch = idx & 15; raw[i] = *(const u32x4*)(Vs + (size_t)(w * 128 + row) * DM + ch * 8); }
    for (int g = 0; g < 8; ++g) {
      __syncthreads();
#pragma unroll
      for (int i = 0; i < 4; ++i) {
        const int idx = tid + 512 * i, row = idx >> 4, ch = idx & 15; const int c0 = g * 128 + ch * 8;
        const u32x4 v = raw[i];
        const float mu = stats[2 * row], rs = stats[2 * row + 1];
        const f32x4 g0 = *(const f32x4*)(p.ln_g + c0), g1 = *(const f32x4*)(p.ln_g + c0 + 4), b0 = *(const f32x4*)(p.ln_b + c0), b1 = *(const f32x4*)(p.ln_b + c0 + 4);
        u32x4 o;
        o.x = pk2((bf_lo(v.x) - mu) * rs * g0[0] + b0[0], (bf_hi(v.x) - mu) * rs * g0[1] + b0[1]);
        o.y = pk2((bf_lo(v.y) - mu) * rs * g0[2] + b0[2], (bf_hi(v.y) - mu) * rs * g0[3] + b0[3]);
        o.z = pk2((bf_lo(v.z) - mu) * rs * g1[0] + b1[0], (bf_hi(v.z) - mu) * rs * g1[1] + b1[1]);
        o.w = pk2((bf_lo(v.w) - mu) * rs * g1[2] + b1[2], (bf_hi(v.w) - mu) * rs * g1[3] + b1[3]);
        *LDSP(u32x4, shm + off_a(row, ch)) = o;
      }
      if (g + 1 < 8) {
#pragma unroll
        for (int i = 0; i < 4; ++i) { const int idx = tid + 512 * i, row = idx >> 4, ch = idx & 15; raw[i] = *(const u32x4*)(Vs + (size_t)(w * 128 + row) * DM + (g + 1) * 128 + ch * 8); }
      }
      __syncthreads();
      const int ib = wid & 3, chalf = wid >> 2, nks = (ib < 2) ? 4 : 8;
      f32x16 acc[2];
#pragma unroll
      for (int cc = 0; cc < 2; ++cc)
#pragma unroll
        for (int i = 0; i < 16; ++i) acc[cc][i] = 0.f;
      const bf16_t* wrow = wm + ((size_t)(g * 128 + ib * 32 + l31)) * 128 + 8 * h;
      for (int ks = 0; ks < nks; ++ks) {
        const bf16x8 bfr = *(const bf16x8*)(wrow + 16 * ks);
#pragma unroll
        for (int cc = 0; cc < 2; ++cc) {
          const unsigned chb = 4 * (2 * chalf + cc) + 2 * blk + (pp >> 1);
          const bf16x8 af = tr_pair(shm + off_a(16 * ks + 8 * h + q4, chb) + 8 * (pp & 1), shm + off_a(16 * ks + 8 * h + 4 + q4, chb) + 8 * (pp & 1));
          acc[cc] = MFMA32(af, bfr, acc[cc]);
        }
      }
      const int tok = w * 128 + ib * 32 + l31; const float bias = p.sg_b[g * 128 + ib * 32 + l31];
#pragma unroll
      for (int cc = 0; cc < 2; ++cc)
#pragma unroll
        for (int g4 = 0; g4 < 4; ++g4) {
          bf16_t* up = U + (size_t)tok * DM + g * 128 + 32 * (2 * chalf + cc) + 8 * g4 + 4 * h;
          const u32x2 uu = *(const u32x2*)up; f32x4 o;
          o[0] = bf_lo(uu.x) * (acc[cc][4 * g4 + 0] + bias); o[1] = bf_hi(uu.x) * (acc[cc][4 * g4 + 1] + bias);
          o[2] = bf_lo(uu.y) * (acc[cc][4 * g4 + 2] + bias); o[3] = bf_hi(uu.y) * (acc[cc][4 * g4 + 3] + bias);
          st_bf4(up, o);
        }
    }
  }
}

DI void final_phase(const Params& p) {
  const float* ssq = (const float*)(p.ws + OFF_SSQ) + 2 * T_TOK;
  const int gt = blockIdx.x * NTHR + tidx(), gn = gridDim.x * NTHR;
  for (int i = gt; i < T_TOK * DM / 4; i += gn) {
    const int row = i >> 8, c4 = (i & 255) * 4; const float rs = rsqrtf(ssq[row] * (1.0f / DM) + RMS_EPS);
    f32x4 v = *(f32x4*)(p.out + (size_t)i * 4); v = v * rs * *(const f32x4*)(p.g_final + c4); *(f32x4*)(p.out + (size_t)i * 4) = v;
  }
}


#define XB_TMO      128
#define XB_XCNT(j)  (256  + 64 * (j))
#define XB_XSUB(j)  (1280 + 64 * (j))
#define XB_XGEN(j)  (2304 + 64 * (j))
#define XB_TOP      3328
#define XB_TOPGEN   3392
#define XCD_BAR_WORDS 3456
#define XB_SPIN_CAP (1u << 18)
DI unsigned xb_ld(unsigned* p) { return __hip_atomic_load(p, __ATOMIC_RELAXED, __HIP_MEMORY_SCOPE_AGENT); }
DI unsigned xb_add(unsigned* p, unsigned v) { return __hip_atomic_fetch_add(p, v, __ATOMIC_RELAXED, __HIP_MEMORY_SCOPE_AGENT); }
DI unsigned xb_xcc_id() { return (unsigned)__builtin_amdgcn_s_getreg((3 << 11) | 20) & 0xFu; }
#define XB_SPIN(cond, bar) do { unsigned _sp = 0; while (cond) { __builtin_amdgcn_s_sleep(1); \
    if ((++_sp & 255u) == 0u) { if (xb_ld(&(bar)[XB_TMO])) break; if (_sp > XB_SPIN_CAP) { atomicAdd(&(bar)[XB_TMO], 1u); break; } } } } while (0)
struct XcdBarrier { unsigned* bar; unsigned x, nloc, nx; };
DI unsigned xcd_barrier_post(unsigned* bar) { const unsigned x = xb_xcc_id(); if (threadIdx.x == 0) (void)xb_add(&bar[XB_XCNT(x)], 1u); return x; }
DI void xcd_barrier_complete(unsigned* bar, unsigned x, unsigned& nloc, unsigned& nx) {
  const unsigned G = gridDim.x * gridDim.y * gridDim.z;
  unsigned sum, cnt, mine, sp = 0u;
  for (;;) {
    sum = 0u; cnt = 0u; mine = 0u;
#pragma unroll
    for (unsigned j = 0; j < 16; ++j) { const unsigned c = xb_ld(&bar[XB_XCNT(j)]); sum += c; cnt += (c > 0u) ? 1u : 0u; mine = (j == x) ? c : mine; }
    if (sum == G) break;
    __builtin_amdgcn_s_sleep(1);
    if ((++sp & 255u) == 0u) { if (xb_ld(&bar[XB_TMO])) break; if (sp > XB_SPIN_CAP) { atomicAdd(&bar[XB_TMO], 1u); break; } }
  }
  nloc = mine > 0u ? mine : 1u; nx = cnt > 0u ? cnt : 1u;
}
DI void xcd_barrier(const XcdBarrier& b) {
  asm volatile("s_waitcnt vmcnt(0)" ::: "memory");
  __syncthreads();
  if (threadIdx.x == 0) {
    unsigned* bar = b.bar;
    __builtin_amdgcn_s_waitcnt(0);
    const unsigned nloc = b.nloc, nx = b.nx;
    const unsigned old = xb_add(&bar[XB_XSUB(b.x)], 1u);
    const unsigned gen = old / nloc;
    if (old + 1u == (gen + 1u) * nloc) {
      __builtin_amdgcn_fence(__ATOMIC_RELEASE, "agent");
      asm volatile("s_waitcnt vmcnt(0)" ::: "memory");
      const unsigned og = xb_add(&bar[XB_TOP], 1u);
      const unsigned tg = og / nx;
      if (og + 1u == (tg + 1u) * nx) xb_add(&bar[XB_TOPGEN], 1u);
      else XB_SPIN(xb_ld(&bar[XB_TOPGEN]) == tg, bar);
      __builtin_amdgcn_fence(__ATOMIC_ACQUIRE, "agent");
      xb_add(&bar[XB_XGEN(b.x)], 1u);
      asm volatile("s_waitcnt vmcnt(0)" ::: "memory");
    } else {
      XB_SPIN(xb_ld(&bar[XB_XGEN(b.x)]) == gen, bar);
      __builtin_amdgcn_fence(__ATOMIC_ACQUIRE, "agent");
      asm volatile("s_waitcnt vmcnt(0)" ::: "memory");
    }
  }
  __syncthreads();
}

constexpr int N_PHASES = 12;
template <int PH> DI void run_phase(const Params& p, lds_t* shm) {
  float* ssq = (float*)(p.ws + OFF_SSQ);
  if (PH == 0) prep_phase(p, shm);
  else if (PH == 1) {
    g8::gemm_phase<GSP2, GALIGN>(slot(p, 0), wt(p, W_IN), T_TOK, 7168, 1024, EpiProj{p}, shm);
    g8::gemm_phase<GSP2, GALIGN>((const bf16_t*)(p.ws + OFF_MEMN), wt(p, W_XKV), 1024, 2048, 1024, EpiPlainBf16{(bf16_t*)(p.ws + OFF_KVX), 2048}, shm);
  }
  else if (PH == 2) {}
  else if (PH == 3) { sg_phase(p, shm); diff_attn_phase(p, shm); }
  else if (PH == 4) merged_phase(p, shm);
  else if (PH == 5) g8::gemm_phase<GSP2, GALIGN>(slot(p, 1), wt(p, W_OUT), T_TOK, 1024, 1024, EpiResid{p.x, nullptr, nullptr, slot(p, 2), ssq}, shm);
  else if (PH == 6) { g8::gemm_phase<GSP2, GALIGN>(slot(p, 2), wt(p, W_XQ), T_TOK, 1024, 1024, EpiRowScale{slot(p, 3), 1024, ssq, 0.0625f * LOG2E, 0}, shm); cross_attn_own_tiles(p, shm); }
  else if (PH == 7) {}
  else if (PH == 8) g8::gemm_phase<GSP2, GALIGN>(slot(p, 0), wt(p, W_XO), T_TOK, 1024, 1024, EpiResid{nullptr, slot(p, 2), nullptr, slot(p, 1), ssq + T_TOK}, shm);
  else if (PH == 9) g8::gemm_phase<GSP2, GALIGN>(slot(p, 1), wt(p, W_FF1), T_TOK, 4096, 1024, EpiRowScale{slot(p, 2), 4096, ssq + T_TOK, 1.0f, 1}, shm);
  else if (PH == 10) {
    if (gridDim.x == 256) g8::gemm_phase<GSP2, true>(slot(p, 2), wt(p, W_FF2), T_TOK, 1024, 4096, EpiResidFinal{slot(p, 1), p.out, ssq + 2 * T_TOK, (unsigned*)(p.ws + OFF_BAR) + 3584, p.g_final}, shm);
    else g8::gemm_phase<GSP2, GALIGN>(slot(p, 2), wt(p, W_FF2), T_TOK, 1024, 4096, EpiResid{nullptr, slot(p, 1), p.out, nullptr, ssq + 2 * T_TOK}, shm);
  }
  else if (PH == 11) { if (gridDim.x != 256) final_phase(p); }
}

extern __shared__ __attribute__((aligned(16))) unsigned char smem_raw[];

#if !MK_COOP
template <int PH> __global__ void __launch_bounds__(NTHR) phase_kernel(Params p) { run_phase<PH>(p, (lds_t*)smem_raw); }
template <int PH> static void launch_phases(const Params& p, int grid, hipStream_t stream) {
  (void)hipFuncSetAttribute((const void*)phase_kernel<PH>, hipFuncAttributeMaxDynamicSharedMemorySize, SMEM_BYTES);
  hipLaunchKernelGGL(phase_kernel<PH>, dim3(grid), dim3(NTHR), SMEM_BYTES, stream, p);
  if constexpr (PH + 1 < N_PHASES) launch_phases<PH + 1>(p, grid, stream);
}
#else

template <int PH> DI void run_from(const Params& p, lds_t* shm, cg::grid_group& grid, const XcdBarrier& xb) {
  run_phase<PH>(p, shm);
  if constexpr (PH + 1 < N_PHASES) { if (PH != 2 && PH != 6 && !(PH == 10 && gridDim.x == 256)) xcd_barrier(xb); run_from<PH + 1>(p, shm, grid, xb); }
}
__global__ void __launch_bounds__(NTHR) mega_kernel(Params p) {
  cg::grid_group grid = cg::this_grid();
  if (p.ws == nullptr) grid.sync();
  XcdBarrier xb; xb.bar = (unsigned*)(p.ws + OFF_BAR); xb.x = xcd_barrier_post(xb.bar);
  { __attribute__((address_space(3))) unsigned* t = LDSP(unsigned, smem_raw);
    if (threadIdx.x == 0) { unsigned nloc, nx; xcd_barrier_complete(xb.bar, xb.x, nloc, nx); t[0] = nloc; t[1] = nx; }
    __syncthreads();
    xb.nloc = __builtin_amdgcn_readfirstlane(t[0]); xb.nx = __builtin_amdgcn_readfirstlane(t[1]);
    __syncthreads(); }
  run_from<0>(p, (lds_t*)smem_raw, grid, xb);
}

#endif

extern "C" void kernel_launch(void* const* d_in, const int* in_sizes, int n_in, void* d_out, int out_size, void* d_ws, size_t ws_size, hipStream_t stream) {
  Params p{};
  p.x = (const float*)d_in[0]; p.mem = (const float*)d_in[1]; p.pos = (const int*)d_in[2];
  p.g_mix = (const float*)d_in[3]; p.w_in = (const float*)d_in[4]; p.lq1 = (const float*)d_in[5]; p.lk1 = (const float*)d_in[6]; p.lq2 = (const float*)d_in[7]; p.lk2 = (const float*)d_in[8];
  p.g_subln = (const float*)d_in[9]; p.ln_g = (const float*)d_in[10]; p.ln_b = (const float*)d_in[11]; p.sg_w = (const float*)d_in[12]; p.sg_b = (const float*)d_in[13];
  p.w_ba = (const float*)d_in[14]; p.w_bs = (const float*)d_in[15]; p.w_out = (const float*)d_in[16]; p.g_xa = (const float*)d_in[17]; p.g_mem = (const float*)d_in[18];
  p.w_xq = (const float*)d_in[19]; p.w_xkv = (const float*)d_in[20]; p.w_xo = (const float*)d_in[21]; p.g_ffn = (const float*)d_in[22]; p.w_ff1 = (const float*)d_in[23]; p.w_ff2 = (const float*)d_in[24];
  p.g_final = (const float*)d_in[25]; p.out = (float*)d_out; p.ws = (unsigned char*)d_ws;
#if MK_COOP
  static int grid_blocks = 0;
  if (!grid_blocks) {
    int dev = 0, cus = 0, per_cu = 0; hipGetDevice(&dev); hipDeviceGetAttribute(&cus, hipDeviceAttributeMultiprocessorCount, dev);
    hipFuncSetAttribute((const void*)mega_kernel, hipFuncAttributeMaxDynamicSharedMemorySize, SMEM_BYTES);
    hipOccupancyMaxActiveBlocksPerMultiprocessor(&per_cu, mega_kernel, NTHR, SMEM_BYTES);
    if (per_cu < 1) per_cu = 1;
    grid_blocks = cus * per_cu;
  }
  (void)hipMemsetAsync((char*)d_ws + OFF_BAR, 0, 16384, stream);
  void* args[] = {&p};
  hipError_t e = hipLaunchCooperativeKernel((const void*)mega_kernel, dim3(grid_blocks), dim3(NTHR), args, SMEM_BYTES, stream);
  if (e != hipSuccess) fprintf(stderr, "cooperative launch failed: %s (grid %d)\n", hipGetErrorString(e), grid_blocks);
#else
  launch_phases<0>(p, 256, stream);
#endif
}
```

```cpp
#include <hip/hip_runtime.h>
#include <hip/hip_cooperative_groups.h>
#include <cstdio>
#include <cstdint>
namespace cg = cooperative_groups;

#ifndef MK_COOP
#define MK_COOP 1
#endif

#define DI __device__ __forceinline__
typedef unsigned short bf16_t;
typedef short bf16x8 __attribute__((ext_vector_type(8)));
typedef short s16x4 __attribute__((ext_vector_type(4)));
typedef float f32x2 __attribute__((ext_vector_type(2)));
typedef float f32x4 __attribute__((ext_vector_type(4)));
typedef float f32x16 __attribute__((ext_vector_type(16)));
typedef unsigned u32x2 __attribute__((ext_vector_type(2)));
typedef unsigned u32x4 __attribute__((ext_vector_type(4)));
typedef __bf16 bf2_t __attribute__((ext_vector_type(2)));
typedef __attribute__((address_space(3))) unsigned char lds_t;
#define LDSP(T, p) ((__attribute__((address_space(3))) T*)(p))

constexpr int T_TOK = 32768, SEQ = 8192, DM = 1024, NTHR = 512;
constexpr float RMS_EPS = 1e-6f, LOG2E = 1.4426950408889634f;
constexpr size_t MiB = 1024 * 1024;
constexpr size_t OFF_ROPE = 0, OFF_SSQ = 2 * MiB, OFF_WM = 3 * MiB, OFF_BAR = 3 * MiB + 512 * 1024, OFF_MEMN = 4 * MiB, OFF_KVX = 6 * MiB, OFF_W = 16 * MiB, OFF_SLOT = 64 * MiB, SLOT = 64 * MiB;
constexpr size_t W_IN = 0, W_BA = 14, W_BS = 16, W_OUT = 18, W_XQ = 20, W_XKV = 22, W_XO = 26, W_FF1 = 28, W_FF2 = 36;
constexpr int SMEM_BYTES = 163840;

struct Params {
  const float *x, *mem; const int* pos;
  const float *g_mix, *w_in, *lq1, *lk1, *lq2, *lk2, *g_subln, *ln_g, *ln_b, *sg_w, *sg_b, *w_ba, *w_bs, *w_out, *g_xa, *g_mem, *w_xq, *w_xkv, *w_xo, *g_ffn, *w_ff1, *w_ff2, *g_final;
  float* out; unsigned char* ws;
};

DI int tidx() { int t = threadIdx.x; asm volatile("" : "+v"(t)); return t; }
DI unsigned pk2(float lo, float hi) { bf2_t v = __builtin_convertvector((f32x2){lo, hi}, bf2_t); return __builtin_bit_cast(unsigned, v); }
DI float bf_lo(unsigned u) { return __uint_as_float(u << 16); }
DI float bf_hi(unsigned u) { return __uint_as_float(u & 0xffff0000u); }
DI float wave_sum(float v) {
  v += __shfl_xor(v, 32); v += __shfl_xor(v, 16); v += __shfl_xor(v, 8); v += __shfl_xor(v, 4); v += __shfl_xor(v, 2); v += __shfl_xor(v, 1); return v;
}
template <class T> DI T gld(const void* base, unsigned off) { return *(const T*)((const char*)base + off); }
template <class T> DI void gst(void* base, unsigned off, T v) { *(T*)((char*)base + off) = v; }
DI bf16_t* slot(const Params& p, int i) { return (bf16_t*)(p.ws + OFF_SLOT + (size_t)i * SLOT); }
DI bf16_t* wt(const Params& p, size_t mib) { return (bf16_t*)(p.ws + OFF_W + mib * MiB); }
#define MFMA32(a, b, c) __builtin_amdgcn_mfma_f32_32x32x16_bf16((a), (b), (c), 0, 0, 0)

#ifndef GSP2
#define GSP2 true
#endif
#ifndef GALIGN
#define GALIGN true
#endif
namespace g8 {
constexpr int BM = 256, BK = 64, HALF = 128, HTB = HALF * BK * 2, NXCD = 8, WGM = 8;
typedef f32x4 Acc[2][2][4][2];
DI int lds_byte(int r, int c) { int st = (r >> 4) * 2 + (c >> 5), rr = r & 15, cc = c & 31, ob = rr * 64 + cc * 2; return st * 1024 + (ob ^ (((ob >> 9) & 1) << 5)); }
DI void stage_rc(int b, int& R, int& C) { int st = b / 1024, sb = b % 1024, swz = sb ^ (((sb >> 9) & 1) << 5); R = (st >> 1) * 16 + swz / 64; C = (st & 1) * 32 + (swz % 64) / 2; }

DI int perm32(int rho) { const int n = rho >> 4, i = rho & 15; return 8 * (i >> 2) + 4 * n + (i & 3); }
DI bool tile_coords(int L, int nM, int nN, int& pm, int& pn) {
  const int nwg = nM * nN; if (L >= nwg) return false;
  int wgid = L; { const int q = nwg / NXCD, r = nwg % NXCD, xcd = wgid % NXCD, off = wgid / NXCD; wgid = (xcd < r ? xcd * (q + 1) : r * (q + 1) + (xcd - r) * q) + off; }
  const int nig = WGM * nN, gid = wgid / nig, fm = gid * WGM, gsz = (nM - fm) < WGM ? (nM - fm) : WGM;
  pm = fm + ((wgid % nig) % gsz); pn = (wgid % nig) / gsz; return true;
}

DI void zero_acc(Acc& acc) {
#pragma unroll
  for (int a = 0; a < 2; ++a)
#pragma unroll
    for (int b = 0; b < 2; ++b)
#pragma unroll
      for (int m = 0; m < 4; ++m)
#pragma unroll
        for (int n = 0; n < 2; ++n) acc[a][b][m][n] = (f32x4){0.f, 0.f, 0.f, 0.f};
}

template <class F> DI void epi_loop(Acc& acc, int pm, int pn, int wr, int wc, int fr, int fq, F&& f) {
#pragma unroll
  for (int ai = 0; ai < 2; ++ai)
#pragma unroll
    for (int m = 0; m < 4; ++m) {
      const int row = pm * BM + ai * HALF + wr * 64 + m * 16 + fr;
#pragma unroll
      for (int bj = 0; bj < 2; ++bj) { const int col8 = pn * BM + wc * 64 + bj * 32 + fq * 8; f(row, col8, acc[ai][bj][m][0], acc[ai][bj][m][1]); }
    }
}
DI u32x4 pk8(const f32x4& a, const f32x4& b) { u32x4 w; w.x = pk2(a[0], a[1]); w.y = pk2(a[2], a[3]); w.z = pk2(b[0], b[1]); w.w = pk2(b[2], b[3]); return w; }
template <bool NT = false> DI void st_rows16(void* base, unsigned pitch_b, unsigned row0, unsigned col0, int fr, int fq, const u32x4& w0, const u32x4& w1) {
  u32x4 x;
#pragma unroll
  for (int e = 0; e < 4; ++e) x[e] = (unsigned)__builtin_amdgcn_update_dpp(0, (int)w1[e], 0x128  , 0xf, 0xf, false);
  const bool hi = fr >= 8;
  u32x4 pa, pb;
#pragma unroll
  for (int e = 0; e < 4; ++e) { pa[e] = hi ? x[e] : w0[e]; pb[e] = hi ? w0[e] : x[e]; }
  const unsigned ra = row0 + (unsigned)(fr & 7), ca = col0 + 8u * fq + (hi ? 32u : 0u), cb = col0 + 8u * fq + (hi ? 0u : 32u);
  if (NT) { __builtin_nontemporal_store(pa, (u32x4*)((char*)base + (ra * pitch_b + ca * 2u))); __builtin_nontemporal_store(pb, (u32x4*)((char*)base + ((ra + 8u) * pitch_b + cb * 2u))); }
  else { gst<u32x4>(base, ra * pitch_b + ca * 2u, pa); gst<u32x4>(base, (ra + 8u) * pitch_b + cb * 2u, pb); }
}
DI void unpk8(const u32x4& w, f32x4& a, f32x4& b) { a[0] = bf_lo(w.x); a[1] = bf_hi(w.x); a[2] = bf_lo(w.y); a[3] = bf_hi(w.y); b[0] = bf_lo(w.z); b[1] = bf_hi(w.z); b[2] = bf_lo(w.w); b[3] = bf_hi(w.w); }

template <bool SP2, bool ALIGN_EPI, bool DUAL, class Epi> DI void gemm_phase2(const bf16_t* A, const bf16_t* Bt, const bf16_t* A2, const bf16_t* Bt2, int M, int N, int K, const Epi& E, lds_t* lds) {
  const int nM = M / BM, nN = N / BM, G = gridDim.x, cb = blockIdx.x;
  const int tid = tidx(), wid = __builtin_amdgcn_readfirstlane(tid >> 6), lane = tid & 63, wr = wid >> 2, wc = wid & 3, fr = lane & 15, fq = lane >> 4;
  const int nt = K / BK;
  unsigned voffA[2], voffB[2];
#pragma unroll
  for (int i = 0; i < 2; ++i) { int R, C; stage_rc(tid * 16 + i * 8192, R, C); const int Rb = (R >> 5) * 64 + perm32(R & 31);
    voffA[i] = (unsigned)(R * K + C) * 2u; voffB[i] = (unsigned)(Rb * K + C) * 2u; }
  const size_t kstep = (size_t)(BK * 2), hstep = (size_t)HALF * K * 2, tstep = 2 * hstep, bstep = (size_t)32 * K * 2;
  const unsigned ldsw = (unsigned)wid * 1024u;
  const int aoff = lds_byte(wr * 64 + fr, fq * 8), boff = lds_byte(wc * 32 + fr, fq * 8);
#define SA(b, h) (((b) * 2 + (h)) * HTB)
#define SB(b, h) ((4 + (b) * 2 + (h)) * HTB)
#define STAGE_(bufoff, gbase, voff) do { _Pragma("unroll") for (int _i = 0; _i < 2; ++_i) \
    __builtin_amdgcn_global_load_lds((const __attribute__((address_space(1))) unsigned*)((const char*)(gbase) + voff[_i]), LDSP(unsigned, lds + (bufoff) + ldsw + _i * 8192), 16, 0, 0); } while (0)
#define STAGE(bufoff, gbase) STAGE_(bufoff, gbase, voffA)
#define STAGEB(bufoff, gbase) STAGE_(bufoff, gbase, voffB)
#define LDA(dst, b, h) do { _Pragma("unroll") for (int m = 0; m < 4; ++m) _Pragma("unroll") for (int k = 0; k < 2; ++k) dst[m][k] = *LDSP(const bf16x8, lds + SA(b, h) + aoff + m * 2048 + k * 1024); } while (0)
#define LDB(dst, b, h) do { _Pragma("unroll") for (int n = 0; n < 2; ++n) _Pragma("unroll") for (int k = 0; k < 2; ++k) dst[n][k] = *LDSP(const bf16x8, lds + SB(b, h) + boff + n * 2048 + k * 1024); } while (0)
#define MMA(ai, bj, AT, BT) do { __builtin_amdgcn_s_setprio(1); \
    _Pragma("unroll") for (int m = 0; m < 4; ++m) _Pragma("unroll") for (int n = 0; n < 2; ++n) _Pragma("unroll") for (int k = 0; k < 2; ++k) \
      acc[ai][bj][m][n] = __builtin_amdgcn_mfma_f32_16x16x32_bf16(BT[n][k], AT[m][k], acc[ai][bj][m][n], 0, 0, 0); \
    __builtin_amdgcn_s_setprio(0); } while (0)
#define WAIT_V(n) asm volatile("s_waitcnt vmcnt(" #n ")" ::: "memory")
#define WAIT_L(n) asm volatile("s_waitcnt lgkmcnt(" #n ")" ::: "memory")
#define BAR __builtin_amdgcn_s_barrier()
#define SCHED __builtin_amdgcn_sched_barrier(0)
  int pm, pn, npm = 0, npn = 0, ui = 0, pass = 0;
  if (!tile_coords(cb, nM, nN, pm, pn)) return;
  Acc acc; zero_acc(acc);
  bf16x8 At[4][2], B0[2][2], B1[2][2];
  const char* cA = (const char*)A + (size_t)pm * tstep; const char* cB = (const char*)Bt + (size_t)pn * tstep;
  if constexpr (SP2) {
    STAGEB(SB(0, 0), cB); STAGEB(SB(0, 1), cB + bstep); STAGE(SA(0, 0), cA); STAGE(SA(0, 1), cA + hstep);
    if (wr == 1) BAR;
    WAIT_V(2); BAR;
    STAGEB(SB(1, 0), cB + kstep); STAGE(SA(1, 0), cA + kstep); STAGEB(SB(1, 1), cB + bstep + kstep);
    WAIT_V(6); BAR;
  } else {
    STAGEB(SB(0, 0), cB); STAGE(SA(0, 0), cA); STAGEB(SB(0, 1), cB + bstep); STAGE(SA(0, 1), cA + hstep);
    if (wr == 1) BAR;
    WAIT_V(4); BAR;
    STAGEB(SB(1, 0), cB + kstep); STAGE(SA(1, 0), cA + kstep); STAGEB(SB(1, 1), cB + bstep + kstep);
    WAIT_V(6); BAR;
  }
  for (;;) {
    bool has_next; int npass = 0;
    if (DUAL && pass == 0) { has_next = true; npm = pm; npn = pn; npass = 1; }
    else has_next = tile_coords((ui + 1) * G + cb, nM, nN, npm, npn);
    const char* nAb = (const char*)((DUAL && npass) ? A2 : A); const char* nBb = (const char*)((DUAL && npass) ? Bt2 : Bt);
    const char* nA = has_next ? nAb + (size_t)npm * tstep : cA; const char* nB = has_next ? nBb + (size_t)npn * tstep : cB;
    for (int t = 0; t < nt; t += 2) {
      const bool last = (t == nt - 2);
      const char* a1 = cA + (size_t)(t + 1) * kstep;
      const char* a2 = last ? nA : cA + (size_t)(t + 2) * kstep; const char* b2 = last ? nB : cB + (size_t)(t + 2) * kstep;
      const char* a3 = a2 + kstep; const char* b3 = b2 + kstep;
      if constexpr (SP2) {
        LDB(B0, 0, 0); LDB(B1, 0, 1); SCHED; LDA(At, 0, 0); STAGE(SA(1, 1), a1 + hstep);
        WAIT_V(8); WAIT_L(0); BAR; MMA(0, 0, At, B0); MMA(0, 1, At, B1); BAR; SCHED;
        LDA(At, 0, 1); STAGEB(SB(0, 0), b2); STAGEB(SB(0, 1), b2 + bstep); STAGE(SA(0, 0), a2);
        WAIT_V(8); WAIT_L(0); BAR; MMA(1, 0, At, B0); MMA(1, 1, At, B1); BAR; SCHED;
        LDB(B0, 1, 0); LDB(B1, 1, 1); SCHED; LDA(At, 1, 0); STAGE(SA(0, 1), a2 + hstep);
        WAIT_V(8); WAIT_L(0); BAR; MMA(0, 0, At, B0); MMA(0, 1, At, B1); BAR; SCHED;
        LDA(At, 1, 1); STAGEB(SB(1, 0), b3); STAGEB(SB(1, 1), b3 + bstep); STAGE(SA(1, 0), a3);
        WAIT_V(8); WAIT_L(0); BAR; MMA(1, 0, At, B0); MMA(1, 1, At, B1); BAR; SCHED;
      } else {
        LDB(B0, 0, 0); SCHED; LDA(At, 0, 0); STAGE(SA(1, 1), a1 + hstep);
        WAIT_L(8); BAR; WAIT_L(0); MMA(0, 0, At, B0); BAR; SCHED;
        LDB(B1, 0, 1); STAGEB(SB(0, 0), b2);
        BAR; WAIT_L(0); MMA(0, 1, At, B1); BAR;
        LDA(At, 0, 1); STAGE(SA(0, 0), a2);
        BAR; WAIT_L(0); MMA(1, 0, At, B0); BAR; SCHED;
        STAGEB(SB(0, 1), b2 + bstep);
        WAIT_V(6); BAR; MMA(1, 1, At, B1); BAR;
        LDB(B0, 1, 0); SCHED; LDA(At, 1, 0); STAGE(SA(0, 1), a2 + hstep);
        WAIT_L(8); BAR; WAIT_L(0); MMA(0, 0, At, B0); BAR; SCHED;
        LDB(B1, 1, 1); STAGEB(SB(1, 0), b3);
        BAR; WAIT_L(0); MMA(0, 1, At, B1); BAR;
        LDA(At, 1, 1); STAGE(SA(1, 0), a3);
        BAR; WAIT_L(0); MMA(1, 0, At, B0); BAR; SCHED;
        STAGEB(SB(1, 1), b3 + bstep);
        WAIT_V(6); BAR; MMA(1, 1, At, B1); BAR;
      }
    }
    if constexpr (ALIGN_EPI) { if (wr == 0) BAR; }
    if constexpr (DUAL) { if (pass == 0) E.mid(acc, pm, pn, wr, wc, fr, fq); else E(acc, pm, pn, wr, wc, fr, fq); }
    else E(acc, pm, pn, wr, wc, fr, fq);
    if (!has_next) break;
    if (!(DUAL && pass == 0)) { zero_acc(acc); ++ui; }
    pm = npm; pn = npn; cA = nA; cB = nB; pass = npass;
    if constexpr (ALIGN_EPI) { if (wr == 1) BAR; }
  }
  WAIT_V(0);
  if constexpr (!ALIGN_EPI) { if (wr == 0) BAR; }
  BAR;
#undef SA
#undef SB
#undef STAGE
#undef STAGEB
#undef STAGE_
#undef LDA
#undef LDB
#undef MMA
}
template <bool SP2, bool ALIGN_EPI, class Epi> DI void gemm_phase(const bf16_t* A, const bf16_t* Bt, int M, int N, int K, const Epi& E, lds_t* lds) {
  gemm_phase2<SP2, ALIGN_EPI, false>(A, Bt, nullptr, nullptr, M, N, K, E, lds);
}
}

DI void st_bf4(bf16_t* p, f32x4 v) { u32x2 w; w.x = pk2(v[0], v[1]); w.y = pk2(v[2], v[3]); *(u32x2*)p = w; }

struct EpiProj {
  Params p;
  DI void operator()(g8::Acc& acc, int pm, int pn, int wr, int wc, int fr, int fq) const {
    using namespace g8;
    const int seg = pn >> 2;
    const float* rope = (const float*)(p.ws + OFF_ROPE);
    bf16_t* dst; unsigned ld; int cofs;
    if (seg < 5) { dst = slot(p, seg + 1); ld = 1024; cofs = seg * 1024; } else { dst = (bf16_t*)p.out; ld = 2048; cofs = 5 * 1024; }
    const float qs = (seg == 0) ? 0.125f * LOG2E : 1.0f;
    const float sgn = (fq == 0) ? -1.0f : 1.0f; const bool use = fq < 2;
    const unsigned col0 = (unsigned)(pn * BM + wc * 64 - cofs);
#pragma unroll
    for (int ai = 0; ai < 2; ++ai)
#pragma unroll
      for (int m = 0; m < 4; ++m) {
        const int row0 = pm * BM + ai * HALF + wr * 64 + m * 16, row = row0 + fr;
        u32x4 w[2];
#pragma unroll
        for (int bj = 0; bj < 2; ++bj) {
          f32x4 o0 = acc[ai][bj][m][0], o1 = acc[ai][bj][m][1];
          if (seg < 2) {
            if (bj == 0) {
              const f32x4 c0 = gld<f32x4>(rope, (unsigned)row * 64u), c1 = gld<f32x4>(rope, (unsigned)row * 64u + 16u), s0 = gld<f32x4>(rope, (unsigned)row * 64u + 32u) * sgn, s1 = gld<f32x4>(rope, (unsigned)row * 64u + 48u) * sgn;
              f32x4 p0, p1;
#pragma unroll
              for (int e = 0; e < 4; ++e) { p0[e] = __shfl_xor(o0[e], 16); p1[e] = __shfl_xor(o1[e], 16); }
              const f32x4 r0 = o0 * c0 + p0 * s0, r1 = o1 * c1 + p1 * s1;
#pragma unroll
              for (int e = 0; e < 4; ++e) { o0[e] = use ? r0[e] : o0[e]; o1[e] = use ? r1[e] : o1[e]; }
            }
            o0 = o0 * qs; o1 = o1 * qs;
          } else if (seg == 3 || seg == 4) {
#pragma unroll
            for (int e = 0; e < 4; ++e) {
              { const float xx = o0[e], y2 = (-2.0f * 0.7978845608028654f * LOG2E) * (xx + 0.044715f * xx * xx * xx); o0[e] = xx * __builtin_amdgcn_rcpf(1.0f + __builtin_amdgcn_exp2f(y2)); }
              { const float xx = o1[e], y2 = (-2.0f * 0.7978845608028654f * LOG2E) * (xx + 0.044715f * xx * xx * xx); o1[e] = xx * __builtin_amdgcn_rcpf(1.0f + __builtin_amdgcn_exp2f(y2)); }
            }
          } else if (seg >= 5) {
#pragma unroll
            for (int e = 0; e < 4; ++e) { o0[e] = __builtin_amdgcn_rcpf(1.0f + __builtin_amdgcn_exp2f(-LOG2E * o0[e])); o1[e] = __builtin_amdgcn_rcpf(1.0f + __builtin_amdgcn_exp2f(-LOG2E * o1[e])); }
          }
          w[bj] = pk8(o0, o1);
        }
        st_rows16<true>(dst, ld * 2u, (unsigned)row0, col0, fr, fq, w[0], w[1]);
      }
  }
};

struct EpiPlainBf16 {
  bf16_t* dst; int ld;
  DI void operator()(g8::Acc& acc, int pm, int pn, int wr, int wc, int fr, int fq) const {
    using namespace g8;
#pragma unroll
    for (int ai = 0; ai < 2; ++ai)
#pragma unroll
      for (int m = 0; m < 4; ++m)
        st_rows16(dst, (unsigned)ld * 2u, (unsigned)(pm * BM + ai * HALF + wr * 64 + m * 16), (unsigned)(pn * BM + wc * 64), fr, fq, pk8(acc[ai][0][m][0], acc[ai][0][m][1]), pk8(acc[ai][1][m][0], acc[ai][1][m][1]));
  }
};

struct EpiResid {
  const float* resf; const bf16_t* resb; float* outf; bf16_t* outb; float* ssq;
  DI void operator()(g8::Acc& acc, int pm, int pn, int wr, int wc, int fr, int fq) const {
    using namespace g8;
#pragma unroll
    for (int ai = 0; ai < 2; ++ai)
#pragma unroll
      for (int m = 0; m < 4; ++m) {
        const int row = pm * BM + ai * HALF + wr * 64 + m * 16 + fr; float s = 0.f; u32x4 wv[2];
#pragma unroll
        for (int bj = 0; bj < 2; ++bj) {
          const int col8 = pn * BM + wc * 64 + bj * 32 + fq * 8; const unsigned eo = (unsigned)row * DM + (unsigned)col8;
          f32x4 r0, r1;
          if (resf) { r0 = gld<f32x4>(resf, eo * 4u); r1 = gld<f32x4>(resf, eo * 4u + 16u); }
          else unpk8(gld<u32x4>(resb, eo * 2u), r0, r1);
          const f32x4 o0 = r0 + acc[ai][bj][m][0], o1 = r1 + acc[ai][bj][m][1];
          if (outf) { gst<f32x4>(outf, eo * 4u, o0); gst<f32x4>(outf, eo * 4u + 16u, o1); }
          wv[bj] = pk8(o0, o1);
          s += o0[0] * o0[0] + o0[1] * o0[1] + o0[2] * o0[2] + o0[3] * o0[3] + o1[0] * o1[0] + o1[1] * o1[1] + o1[2] * o1[2] + o1[3] * o1[3];
        }
        if (outb) st_rows16(outb, DM * 2u, (unsigned)(row - fr), (unsigned)(pn * BM + wc * 64), fr, fq, wv[0], wv[1]);
        s += __shfl_xor(s, 16); s += __shfl_xor(s, 32);
        if (fq == 0) atomicAdd(ssq + row, s);
        __builtin_amdgcn_sched_barrier(0);
      }
  }
};

struct EpiResidFinal {
  const bf16_t* resb; float* outf; float* ssq; unsigned* cnt; const float* g;
  DI void operator()(g8::Acc& acc, int pm, int pn, int wr, int wc, int fr, int fq) const {
    using namespace g8;
#pragma unroll
    for (int ai = 0; ai < 2; ++ai)
#pragma unroll
      for (int m = 0; m < 4; ++m) {
        const int row = pm * BM + ai * HALF + wr * 64 + m * 16 + fr; float sq = 0.f;
#pragma unroll
        for (int bj = 0; bj < 2; ++bj) {
          const int col8 = pn * BM + wc * 64 + bj * 32 + fq * 8; const unsigned eo = (unsigned)row * DM + (unsigned)col8;
          f32x4 r0, r1; unpk8(gld<u32x4>(resb, eo * 2u), r0, r1);
          acc[ai][bj][m][0] = acc[ai][bj][m][0] + r0; acc[ai][bj][m][1] = acc[ai][bj][m][1] + r1;
          const f32x4 o0 = acc[ai][bj][m][0], o1 = acc[ai][bj][m][1];
          sq += o0[0] * o0[0] + o0[1] * o0[1] + o0[2] * o0[2] + o0[3] * o0[3] + o1[0] * o1[0] + o1[1] * o1[1] + o1[2] * o1[2] + o1[3] * o1[3];
        }
        sq += __shfl_xor(sq, 16); sq += __shfl_xor(sq, 32);
        if (fq == 0) atomicAdd(ssq + row, sq);
      }
    asm volatile("s_waitcnt vmcnt(0)" ::: "memory");
    __syncthreads();
    if (threadIdx.x == 0) {
      __hip_atomic_fetch_add(cnt + pm, 1u, __ATOMIC_RELAXED, __HIP_MEMORY_SCOPE_AGENT);
      unsigned sp = 0;
      while (__hip_atomic_load(cnt + pm, __ATOMIC_RELAXED, __HIP_MEMORY_SCOPE_AGENT) < 4u) { __builtin_amdgcn_s_sleep(1); if (++sp > (1u << 22)) break; }
    }
    __syncthreads();
#pragma unroll
    for (int ai = 0; ai < 2; ++ai)
#pragma unroll
      for (int m = 0; m < 4; ++m) {
        const int row = pm * BM + ai * HALF + wr * 64 + m * 16 + fr;
        const float rs = rsqrtf(__hip_atomic_load(ssq + row, __ATOMIC_RELAXED, __HIP_MEMORY_SCOPE_AGENT) * (1.0f / DM) + RMS_EPS);
#pragma unroll
        for (int bj = 0; bj < 2; ++bj) {
          const int col8 = pn * BM + wc * 64 + bj * 32 + fq * 8; const unsigned eo = (unsigned)row * DM + (unsigned)col8;
          gst<f32x4>(outf, eo * 4u, acc[ai][bj][m][0] * rs * gld<f32x4>(g, (unsigned)col8 * 4u));
          gst<f32x4>(outf, eo * 4u + 16u, acc[ai][bj][m][1] * rs * gld<f32x4>(g, (unsigned)col8 * 4u + 16u));
        }
      }
  }
};

struct EpiRowScale {
  bf16_t* dst; int ld; const float* ssq; float sc; int act;
  DI void operator()(g8::Acc& acc, int pm, int pn, int wr, int wc, int fr, int fq) const {
    using namespace g8;
#pragma unroll
    for (int ai = 0; ai < 2; ++ai)
#pragma unroll
      for (int m = 0; m < 4; ++m) {
        const int row = pm * BM + ai * HALF + wr * 64 + m * 16 + fr; const float rs = rsqrtf(ssq[row] * (1.0f / DM) + RMS_EPS) * sc;
        u32x4 wv[2];
#pragma unroll
        for (int bj = 0; bj < 2; ++bj) {
          f32x4 o0 = acc[ai][bj][m][0] * rs, o1 = acc[ai][bj][m][1] * rs;
          if (act) {
#pragma unroll
            for (int e = 0; e < 4; ++e) { const float a = fmaxf(o0[e], 0.f), b = fmaxf(o1[e], 0.f); o0[e] = a * a; o1[e] = b * b; } }
          wv[bj] = pk8(o0, o1);
        }
        st_rows16(dst, (unsigned)ld * 2u, (unsigned)(row - fr), (unsigned)(pn * BM + wc * 64), fr, fq, wv[0], wv[1]);
        __builtin_amdgcn_sched_barrier(0);
      }
  }
};

struct EpiGateDual {
  bf16_t* dst; const bf16_t* gates;
  DI void mid(g8::Acc& acc, int pm, int pn, int wr, int wc, int fr, int fq) const {
    using namespace g8;
#pragma unroll
    for (int ai = 0; ai < 2; ++ai)
#pragma unroll
      for (int m = 0; m < 4; ++m) {
        const int row = pm * BM + ai * HALF + wr * 64 + m * 16 + fr;
#pragma unroll
        for (int bj = 0; bj < 2; ++bj) {
          const int col8 = pn * BM + wc * 64 + bj * 32 + fq * 8; const unsigned go = ((unsigned)row * 2048u + (unsigned)col8) * 2u;
          f32x4 a0, a1, s0, s1; unpk8(gld<u32x4>(gates, go), a0, a1); unpk8(gld<u32x4>(gates, go + 2048u), s0, s1);
#pragma unroll
          for (int e = 0; e < 4; ++e) { acc[ai][bj][m][0][e] *= a0[e] * __builtin_amdgcn_rcpf(fmaxf(s0[e], 1e-30f)); acc[ai][bj][m][1][e] *= a1[e] * __builtin_amdgcn_rcpf(fmaxf(s1[e], 1e-30f)); }
        }
        __builtin_amdgcn_sched_barrier(0);
      }
  }
  DI void operator()(g8::Acc& acc, int pm, int pn, int wr, int wc, int fr, int fq) const {
    using namespace g8;
#pragma unroll
    for (int ai = 0; ai < 2; ++ai)
#pragma unroll
      for (int m = 0; m < 4; ++m) {
        const int row0 = pm * BM + ai * HALF + wr * 64 + m * 16, row = row0 + fr; u32x4 wv[2];
#pragma unroll
        for (int bj = 0; bj < 2; ++bj) {
          const int col8 = pn * BM + wc * 64 + bj * 32 + fq * 8; const unsigned go = ((unsigned)row * 2048u + (unsigned)(1024 + col8)) * 2u;
          f32x4 s0, s1; unpk8(gld<u32x4>(gates, go), s0, s1);
#pragma unroll
          for (int e = 0; e < 4; ++e) { s0[e] = fmaxf(s0[e], 1e-30f); s1[e] = fmaxf(s1[e], 1e-30f); }
          wv[bj] = pk8(acc[ai][bj][m][0] * s0, acc[ai][bj][m][1] * s1);
        }
        st_rows16(dst, DM * 2u, (unsigned)row0, (unsigned)(pn * BM + wc * 64), fr, fq, wv[0], wv[1]);
      }
  }
};
DI void merged_phase(const Params& p, lds_t* shm) {
  g8::gemm_phase2<GSP2, GALIGN, true>(slot(p, 0), wt(p, W_BA), slot(p, 4), wt(p, W_BS), T_TOK, DM, DM, EpiGateDual{slot(p, 1), (const bf16_t*)p.out}, shm);
}

DI void wt_transpose(const float* W, bf16_t* Wt, const float* gain, int K, int N, lds_t* shm) {
  const int tk = K / 64, tn = N / 64, tid = tidx();
  __attribute__((address_space(3))) float* tile = LDSP(float, shm);
  for (int t = blockIdx.x; t < tk * tn; t += gridDim.x) {
    const int k0 = (t / tn) * 64, n0 = (t % tn) * 64;
    const int r = tid >> 4, c4 = (tid & 15) * 4;
#pragma unroll
    for (int i = 0; i < 2; ++i) {
      const int kk = r + 32 * i; f32x4 v = *(const f32x4*)(W + (size_t)(k0 + kk) * N + n0 + c4);
      if (gain) v = v * gain[k0 + kk];
      tile[kk * 65 + c4 + 0] = v[0]; tile[kk * 65 + c4 + 1] = v[1]; tile[kk * 65 + c4 + 2] = v[2]; tile[kk * 65 + c4 + 3] = v[3];
    }
    __syncthreads();
    const int nn = tid >> 3, k8 = (tid & 7) * 8;
    u32x4 w;
    w.x = pk2(tile[(k8 + 0) * 65 + nn], tile[(k8 + 1) * 65 + nn]); w.y = pk2(tile[(k8 + 2) * 65 + nn], tile[(k8 + 3) * 65 + nn]);
    w.z = pk2(tile[(k8 + 4) * 65 + nn], tile[(k8 + 5) * 65 + nn]); w.w = pk2(tile[(k8 + 6) * 65 + nn], tile[(k8 + 7) * 65 + nn]);
    *(u32x4*)(Wt + (size_t)(n0 + nn) * K + k0 + k8) = w;
    __syncthreads();
  }
}

DI void rms_rows(const float* X, const float* g, bf16_t* out, int nrows) {
  const int wid = tidx() >> 6, lane = tidx() & 63; const int stride = gridDim.x * 8;
  for (int r = blockIdx.x * 8 + wid; r < nrows; r += 2 * stride) {
    const int r2 = r + stride; const bool has2 = r2 < nrows;
    const f32x4* xa = (const f32x4*)(X + (size_t)r * DM); const f32x4* xb = (const f32x4*)(X + (size_t)(has2 ? r2 : r) * DM);
    f32x4 va[4], vb[4]; float sa = 0.f, sb = 0.f;
#pragma unroll
    for (int i = 0; i < 4; ++i) { va[i] = xa[lane + 64 * i]; vb[i] = xb[lane + 64 * i]; }
#pragma unroll
    for (int i = 0; i < 4; ++i) { sa += va[i][0] * va[i][0] + va[i][1] * va[i][1] + va[i][2] * va[i][2] + va[i][3] * va[i][3]; sb += vb[i][0] * vb[i][0] + vb[i][1] * vb[i][1] + vb[i][2] * vb[i][2] + vb[i][3] * vb[i][3]; }
    sa = wave_sum(sa); sb = wave_sum(sb);
    const float ra = rsqrtf(sa * (1.0f / DM) + RMS_EPS), rb = rsqrtf(sb * (1.0f / DM) + RMS_EPS);
#pragma unroll
    for (int i = 0; i < 4; ++i) { const f32x4 gg = ((const f32x4*)g)[lane + 64 * i];
      st_bf4(out + (size_t)r * DM + (lane + 64 * i) * 4, va[i] * ra * gg);
      if (has2) st_bf4(out + (size_t)r2 * DM + (lane + 64 * i) * 4, vb[i] * rb * gg); }
  }
}

DI void prep_phase(const Params& p, lds_t* shm) {
  const int gt = blockIdx.x * NTHR + tidx(), gn = gridDim.x * NTHR;
  float* rope = (float*)(p.ws + OFF_ROPE);
  for (int i = gt; i < T_TOK * 8; i += gn) {
    const int t = i >> 3, f = i & 7; const float inv = (float)exp2(-(double)f * 0.125 * 18.931568569324174  );
    const float ang = (float)p.pos[t] * inv; float s, c; sincosf(ang, &s, &c); rope[t * 16 + f] = c; rope[t * 16 + 8 + f] = s;
  }
  float* ssq = (float*)(p.ws + OFF_SSQ);
  for (int i = gt; i < 3 * T_TOK; i += gn) ssq[i] = 0.f;
  bf16_t* wm = (bf16_t*)(p.ws + OFF_WM);
  for (int i = gt; i < 8 * 128 * 128 / 2; i += gn) {
    const int e = i * 2, ii = (e >> 7) & 127, j = e & 127; const f32x2 w = *(const f32x2*)(p.sg_w + e);
    const bool ok = (j >> 6) <= (ii >> 6); ((unsigned*)wm)[i] = ok ? pk2(w[0], w[1]) : 0u;
  }
  rms_rows(p.x, p.g_mix, slot(p, 0), T_TOK);
  rms_rows(p.mem, p.g_mem, (bf16_t*)(p.ws + OFF_MEMN), 1024);
  wt_transpose(p.w_in, wt(p, W_IN), nullptr, 1024, 7168, shm);
  wt_transpose(p.w_ba, wt(p, W_BA), nullptr, 1024, 1024, shm);
  wt_transpose(p.w_bs, wt(p, W_BS), nullptr, 1024, 1024, shm);
  wt_transpose(p.w_out, wt(p, W_OUT), nullptr, 1024, 1024, shm);
  wt_transpose(p.w_xq, wt(p, W_XQ), p.g_xa, 1024, 1024, shm);
  wt_transpose(p.w_xkv, wt(p, W_XKV), nullptr, 1024, 2048, shm);
  wt_transpose(p.w_xo, wt(p, W_XO), nullptr, 1024, 1024, shm);
  wt_transpose(p.w_ff1, wt(p, W_FF1), p.g_ffn, 1024, 4096, shm);
  wt_transpose(p.w_ff2, wt(p, W_FF2), nullptr, 4096, 1024, shm);
}

DI unsigned off_a(unsigned row, unsigned ch) { return 2048u * (row >> 3) + 512u * (ch >> 2) + 64u * (row & 7) + 16u * ((ch & 3) ^ ((row >> 2) & 3)); }
DI void inv_off_a(unsigned L, unsigned& row, unsigned& ch) {
  const unsigned o = L * 16u, b8 = o >> 11, rem = o & 2047u, chq = rem >> 9, rem2 = rem & 511u, r7 = rem2 >> 6, cx = (rem2 & 63u) >> 4;
  row = b8 * 8 + r7; ch = chq * 4 + (cx ^ ((row >> 2) & 3));
}
DI bf16x8 tr_pair(lds_t* a0, lds_t* a1) {
  const s16x4 lo = __builtin_amdgcn_ds_read_tr16_b64_v4i16(LDSP(s16x4, a0)), hi = __builtin_amdgcn_ds_read_tr16_b64_v4i16(LDSP(s16x4, a1));
  return __builtin_shufflevector(lo, hi, 0, 1, 2, 3, 4, 5, 6, 7);
}

DI void glds16(const void* base, unsigned off, lds_t* dst) {
  __builtin_amdgcn_global_load_lds((const __attribute__((address_space(1))) unsigned*)((const char*)base + off), LDSP(unsigned, dst), 16, 0, 0);
}

DI void dattn_unit2(const bf16_t* __restrict__ Qg, const bf16_t* __restrict__ Kg, const bf16_t* __restrict__ Vg, bf16_t* __restrict__ Og,
                    int ntiles, int wave_tiles, float lam, const float* __restrict__ gsub, lds_t* shm) {
  constexpr int NC = 4, LD = DM;
  constexpr unsigned VRING = 3 * 16384;
  const int tid = tidx(), lane = tid & 63, h = lane >> 5, l31 = lane & 31, wid = __builtin_amdgcn_readfirstlane(tid >> 6), grp = wid >> 2;
  unsigned soff[2];
#pragma unroll
  for (int i = 0; i < 2; ++i) { unsigned r, c; inv_off_a(tid + 512 * i, r, c); soff[i] = (r * (unsigned)LD + c * 8u) * 2u; }
  constexpr unsigned tstep = 64u * LD * 2u;
  const int last_tile = ntiles - 1;
  auto issueK = [&](int kt, int slot) __attribute__((always_inline)) {
    const int t = kt < last_tile ? kt : last_tile; lds_t* base = shm + slot * 16384 + wid * 1024; const char* kb = (const char*)Kg + (size_t)t * tstep;
    glds16(kb, soff[0], base); glds16(kb, soff[1], base + 8192);
  };
  auto issueV = [&](int kt, int slot) __attribute__((always_inline)) {
    const int t = kt < last_tile ? kt : last_tile; lds_t* base = shm + VRING + slot * 16384 + wid * 1024; const char* vb = (const char*)Vg + (size_t)t * tstep;
    glds16(vb, soff[0], base); glds16(vb, soff[1], base + 8192);
  };
#define WAIT_V(n) asm volatile("s_waitcnt vmcnt(" #n ")" ::: "memory")
#define BAR do { __builtin_amdgcn_sched_barrier(0); __builtin_amdgcn_s_barrier(); asm volatile("" ::: "memory"); __builtin_amdgcn_sched_barrier(0); } while (0)
  __syncthreads();
  lds_t* Qst = shm + 6 * 16384 + wid * 8192;
#pragma unroll
  for (int i = 0; i < 8; ++i) { unsigned r, c; inv_off_a(lane + 64 * i, r, c); glds16(Qg, (r * (unsigned)LD + c * 8u) * 2u, Qst + i * 1024); }
  issueK(0, 0); issueV(0, 0); issueK(1, 1); issueV(1, 1);
  f32x16 O[2][NC];
#pragma unroll
  for (int m = 0; m < 2; ++m)
#pragma unroll
    for (int c = 0; c < NC; ++c)
#pragma unroll
      for (int i = 0; i < 16; ++i) O[m][c][i] = 0.f;
  float mrun[2] = {-INFINITY, -INFINITY}, lrun[2] = {0.f, 0.f};
  const unsigned q4 = (lane & 15) >> 2, pp = lane & 3, blk = (lane >> 4) & 1;
  const unsigned xk = (l31 >> 2) & 3, kbase = 2048u * (l31 >> 3) + 64u * (l31 & 7);
  const unsigned ka0 = kbase + 16u * ((unsigned)h ^ xk), ka2 = kbase + 16u * ((2u + h) ^ xk);
  const unsigned vrow = 64u * (4u * h + q4), cl = 2u * blk + (pp >> 1);
  const unsigned va0 = VRING + vrow + 16u * (cl ^ (unsigned)h) + 8u * (pp & 1), va1 = VRING + vrow + 16u * (cl ^ ((unsigned)h ^ 2u)) + 8u * (pp & 1);
  WAIT_V(6); BAR;
  if (grp == 1) { WAIT_V(4); BAR; }
  int slot = 0;
  for (int kt = 0; kt < ntiles; ++kt) {
    const int slot2 = slot >= 1 ? slot - 1 : 2;
    issueK(kt + 2, slot2);
    const float msk = (kt < wave_tiles) ? 0.f : -INFINITY;
    const unsigned so = slot * 16384;
    lds_t* K0 = shm + (so + ka0); lds_t* K2 = shm + (so + ka2);
    bf16x8 P[2][2][2]; float alpha[2]; bool resc[2];
#pragma unroll
    for (int m = 0; m < 2; ++m) {
      f32x16 s[2];
#pragma unroll
      for (int kb = 0; kb < 2; ++kb)
#pragma unroll
        for (int i = 0; i < 16; ++i) s[kb][i] = 0.f;
#pragma unroll
      for (int ss = 0; ss < 4; ++ss) {
        const bf16x8 qv = *LDSP(const bf16x8, Qst + ((ss & 1) ? ka2 : ka0) + 512 * (ss >> 1) + 1024 * m);
#pragma unroll
        for (int kb = 0; kb < 2; ++kb) {
          const bf16x8 kf = *LDSP(const bf16x8, ((ss & 1) ? K2 : K0) + kb * 8192 + 512 * (ss >> 1) + 1024 * m);
          s[kb] = MFMA32(kf, qv, s[kb]);
        }
      }
      float mx = s[0][0];
#pragma unroll
      for (int i = 1; i < 16; ++i) mx = fmaxf(mx, s[0][i]);
#pragma unroll
      for (int i = 0; i < 16; ++i) mx = fmaxf(mx, s[1][i]);
      { const auto sw = __builtin_amdgcn_permlane32_swap(__float_as_uint(mx), __float_as_uint(mx), false, false); mx = fmaxf(__uint_as_float(sw[0]), __uint_as_float(sw[1])) + msk; }
      resc[m] = __builtin_amdgcn_ballot_w64(mx > mrun[m] + 8.0f) != 0;
      alpha[m] = 1.0f;
      if (resc[m]) { const float mnew = fmaxf(mrun[m], mx); alpha[m] = __builtin_amdgcn_exp2f(mrun[m] - mnew); mrun[m] = mnew; lrun[m] *= alpha[m]; }
      const float msub = mrun[m] - msk;
      float rs = 0.f;
#pragma unroll
      for (int kb = 0; kb < 2; ++kb)
#pragma unroll
        for (int s2 = 0; s2 < 2; ++s2) {
          float e[8];
#pragma unroll
          for (int j = 0; j < 8; ++j) { e[j] = __builtin_amdgcn_exp2f(s[kb][8 * s2 + j] - msub); rs += e[j]; }
          u32x4 w; w.x = pk2(e[0], e[1]); w.y = pk2(e[2], e[3]); w.z = pk2(e[4], e[5]); w.w = pk2(e[6], e[7]);
          P[m][kb][s2] = __builtin_bit_cast(bf16x8, w);
          __builtin_amdgcn_sched_barrier(0);
        }
      lrun[m] += rs;
      __builtin_amdgcn_sched_barrier(0);
    }
    __builtin_amdgcn_sched_barrier(0);
    WAIT_V(4); BAR;
    issueV(kt + 2, slot2);
    lds_t* V0 = shm + (so + va0); lds_t* V1 = shm + (so + va1);
#pragma unroll
    for (int m = 0; m < 2; ++m)
      if (resc[m]) {
#pragma unroll
        for (int c = 0; c < NC; ++c) O[m][c] = O[m][c] * alpha[m];
      }
#pragma unroll
    for (int ks = 0; ks < 4; ++ks) {
      bf16x8 vf[NC];
#pragma unroll
      for (int c = 0; c < NC; ++c) { const int vo = 512 * c + 4096 * ks; vf[c] = tr_pair(V0 + vo, V1 + vo + 2048); }
#pragma unroll
      for (int c = 0; c < NC; ++c) { O[0][c] = MFMA32(vf[c], P[0][ks >> 1][ks & 1], O[0][c]); O[1][c] = MFMA32(vf[c], P[1][ks >> 1][ks & 1], O[1][c]); }
    }
    __builtin_amdgcn_sched_barrier(0);
    WAIT_V(4); BAR;
    slot = slot == 2 ? 0 : slot + 1;
  }
  if (grp == 0) BAR;
#undef WAIT_V
#undef BAR
  const float l0 = lrun[0] + __shfl_xor(lrun[0], 32), l1 = lrun[1] + __shfl_xor(lrun[1], 32);
  const float i0 = 1.0f / l0, i1 = lam / l1;
  float ssq = 0.f;
#pragma unroll
  for (int c = 0; c < NC; ++c)
#pragma unroll
    for (int i = 0; i < 16; ++i) { const float a = O[0][c][i] * i0 - O[1][c][i] * i1; O[0][c][i] = a; ssq += a * a; }
  ssq += __shfl_xor(ssq, 32);
  const float inv = rsqrtf(ssq * (1.0f / 128.0f) + RMS_EPS) * 0.8f;
  const int lane_f = tidx() & 63, h_f = lane_f >> 5;
  const unsigned ooff = ((unsigned)(lane_f & 31) * (unsigned)LD + 4u * h_f) * 2u;
#pragma unroll
  for (int c = 0; c < NC; ++c)
#pragma unroll
    for (int g4 = 0; g4 < 4; ++g4) {
      const int dv0 = 32 * c + 8 * g4; f32x4 o;
#pragma unroll
      for (int e = 0; e < 4; ++e) o[e] = O[0][c][4 * g4 + e] * inv;
      o = o * gld<f32x4>(gsub + dv0, 16u * h_f);
      u32x2 w; w.x = pk2(o[0], o[1]); w.y = pk2(o[2], o[3]);
      gst<u32x2>(Og + dv0, ooff, w);
    }
}

DI void diff_attn_phase(const Params& p, lds_t* shm) {
  const int wid = __builtin_amdgcn_readfirstlane(tidx() >> 6), lane = tidx() & 63;
  const float d1 = wave_sum(p.lq1[lane] * p.lk1[lane]), d2 = wave_sum(p.lq2[lane] * p.lk2[lane]);
  const float lam = __uint_as_float(__builtin_amdgcn_readfirstlane(__float_as_uint(expf(d1) - expf(d2) + 0.2f)));
  const bf16_t *Q = slot(p, 1), *K = slot(p, 2), *V = slot(p, 3); bf16_t* A = slot(p, 0);
  const int nit = (gridDim.x == 256) ? 2 : (512 + gridDim.x - 1) / gridDim.x;
  for (int it = 0; it < nit; ++it) {
    int pi;
    if (gridDim.x == 256) pi = 0;
    else { pi = blockIdx.x + it * gridDim.x; if (pi >= 512) break; }
    const int bh = pi >> 4, pp = pi & 15, b = bh >> 3, hd = bh & 7;
    for (int e = 0; e < 2; ++e) {
      int qb = e ? pp : 31 - pp; int bb = b, hh = hd;
      if (gridDim.x == 256) { const int x = blockIdx.x & 7, j = blockIdx.x >> 3, bh2 = 4 * x + 2 * it + e; bb = bh2 >> 3; hh = bh2 & 7; qb = e ? 31 - j : j; }
      const size_t r0 = (size_t)bb * SEQ + qb * 256 + wid * 32;
      dattn_unit2(Q + r0 * DM + hh * 128, K + (size_t)bb * SEQ * DM + hh * 128, V + (size_t)bb * SEQ * DM + hh * 128, A + r0 * DM + hh * 128,
                  qb * 4 + 4, qb * 4 + (wid >> 1) + 1, lam, p.g_subln, shm);
    }
  }
}

DI void xattn_unit(const bf16_t* __restrict__ Qg, const bf16_t* __restrict__ Kg, const bf16_t* __restrict__ Vg, bf16_t* __restrict__ Og, lds_t* shm) {
  constexpr int LDQ = DM, LDKV = 2048, NC = 8;
  const int tid = tidx(), lane = tid & 63, h = lane >> 5, l31 = lane & 31, wid = __builtin_amdgcn_readfirstlane(tid >> 6);
  unsigned soff[2];
#pragma unroll
  for (int i = 0; i < 2; ++i) { unsigned r, c; inv_off_a(tid + 512 * i, r, c); soff[i] = (r * (unsigned)LDKV + c * 8u) * 2u; }
  constexpr unsigned tstep = 64u * LDKV * 2u;
  auto issue_tile = [&](const bf16_t* src, int t, unsigned lds_base) __attribute__((always_inline)) {
    const char* sb = (const char*)src + (size_t)t * tstep; lds_t* base = shm + lds_base + wid * 1024;
#pragma unroll
    for (int im = 0; im < 2; ++im) { glds16(sb + im * 256, soff[0], base + im * 16384); glds16(sb + im * 256, soff[1], base + im * 16384 + 8192); }
  };
  __syncthreads();
#pragma unroll
  for (int t = 0; t < 4; ++t) issue_tile(Kg, t, t * 32768);
  issue_tile(Vg, 0, 131072);
  const unsigned q4 = (lane & 15) >> 2, pp = lane & 3, blk = (lane >> 4) & 1;
  const unsigned xk = (l31 >> 2) & 3, kbase = 2048u * (l31 >> 3) + 64u * (l31 & 7);
  const unsigned ka0 = kbase + 16u * ((unsigned)h ^ xk), ka2 = kbase + 16u * ((2u + h) ^ xk);
  const unsigned vrow = 64u * (4u * h + q4), cl = 2u * blk + (pp >> 1);
  const unsigned va0 = vrow + 16u * (cl ^ (unsigned)h) + 8u * (pp & 1), va1 = vrow + 16u * (cl ^ ((unsigned)h ^ 2u)) + 8u * (pp & 1);
  const unsigned qoff = ((unsigned)l31 * (unsigned)LDQ + 8u * h) * 2u;
  f32x16 S[4][2];
#pragma unroll
  for (int t = 0; t < 4; ++t)
#pragma unroll
    for (int kb = 0; kb < 2; ++kb)
#pragma unroll
      for (int i = 0; i < 16; ++i) S[t][kb][i] = 0.f;
  asm volatile("s_waitcnt vmcnt(0)" ::: "memory");
  __syncthreads();
  __builtin_amdgcn_sched_barrier(0);
#pragma unroll
  for (int ss = 0; ss < 16; ++ss) {
    const int cgl = 2 * ss, img = cgl >> 4;
    const bf16x8 qv = gld<bf16x8>(Qg + 16 * ss, qoff);
#pragma unroll
    for (int t = 0; t < 4; ++t)
#pragma unroll
      for (int kb = 0; kb < 2; ++kb) {
        const bf16x8 kf = *LDSP(const bf16x8, shm + t * 32768 + img * 16384 + kb * 8192 + 512 * ((cgl & 15) >> 2) + ((cgl & 2) ? ka2 : ka0));
        S[t][kb] = MFMA32(kf, qv, S[t][kb]);
      }
  }
  float mx = S[0][0][0];
#pragma unroll
  for (int t = 0; t < 4; ++t)
#pragma unroll
    for (int kb = 0; kb < 2; ++kb)
#pragma unroll
      for (int i = 0; i < 16; ++i) mx = fmaxf(mx, S[t][kb][i]);
  { const auto sw = __builtin_amdgcn_permlane32_swap(__float_as_uint(mx), __float_as_uint(mx), false, false); mx = fmaxf(__uint_as_float(sw[0]), __uint_as_float(sw[1])); }
  float rs = 0.f;
  bf16x8 P[4][2][2];
#pragma unroll
  for (int t = 0; t < 4; ++t)
#pragma unroll
    for (int kb = 0; kb < 2; ++kb)
#pragma unroll
      for (int s2 = 0; s2 < 2; ++s2) {
        float e[8];
#pragma unroll
        for (int j = 0; j < 8; ++j) { e[j] = __builtin_amdgcn_exp2f(S[t][kb][8 * s2 + j] - mx); rs += e[j]; }
        u32x4 w; w.x = pk2(e[0], e[1]); w.y = pk2(e[2], e[3]); w.z = pk2(e[4], e[5]); w.w = pk2(e[6], e[7]);
        P[t][kb][s2] = __builtin_bit_cast(bf16x8, w);
      }
  const float l = rs + __shfl_xor(rs, 32);
  __builtin_amdgcn_sched_barrier(0);
  __syncthreads();
  __builtin_amdgcn_sched_barrier(0);
#pragma unroll
  for (int t = 1; t < 4; ++t) issue_tile(Vg, t, t * 32768);
  f32x16 O[NC];
#pragma unroll
  for (int c = 0; c < NC; ++c)
#pragma unroll
    for (int i = 0; i < 16; ++i) O[c][i] = 0.f;
#pragma unroll
  for (int t = 0; t < 4; ++t) {
    if (t == 1) { __builtin_amdgcn_sched_barrier(0); asm volatile("s_waitcnt vmcnt(0)" ::: "memory"); __syncthreads(); __builtin_amdgcn_sched_barrier(0); }
    const unsigned vbase = (t == 0) ? 131072u : (unsigned)t * 32768u;
#pragma unroll
    for (int ks = 0; ks < 4; ++ks)
#pragma unroll
      for (int c = 0; c < NC; ++c) {
        const unsigned vo = vbase + (c >> 2) * 16384 + 512 * (c & 3) + 4096 * ks;
        const bf16x8 vf = tr_pair(shm + vo + va0, shm + vo + 2048 + va1);
        O[c] = MFMA32(vf, P[t][ks >> 1][ks & 1], O[c]);
      }
  }
  const float inv = 1.0f / l;
  const unsigned ooff = ((unsigned)l31 * (unsigned)LDQ + 4u * h) * 2u;
#pragma unroll
  for (int c = 0; c < NC; ++c)
#pragma unroll
    for (int g4 = 0; g4 < 4; ++g4) {
      u32x2 w; w.x = pk2(O[c][4 * g4 + 0] * inv, O[c][4 * g4 + 1] * inv); w.y = pk2(O[c][4 * g4 + 2] * inv, O[c][4 * g4 + 3] * inv);
      gst<u32x2>(Og + 32 * c + 8 * g4, ooff, w);
    }
}

DI void cross_attn_own_tiles(const Params& p, lds_t* shm) {
  const int wid = __builtin_amdgcn_readfirstlane(tidx() >> 6);
  const bf16_t* Q = slot(p, 3); const bf16_t* KV = (const bf16_t*)(p.ws + OFF_KVX); bf16_t* O = slot(p, 0);
  for (int i = 0;; ++i) {
    int pm, pn; if (!g8::tile_coords(i * (int)gridDim.x + (int)blockIdx.x, T_TOK / 256, 4, pm, pn)) break;
    const int b = pm >> 5, hd = pn; const size_t r0 = (size_t)pm * 256 + wid * 32;
    xattn_unit(Q + r0 * DM + hd * 256, KV + (size_t)b * 256 * 2048 + hd * 256, KV + (size_t)b * 256 * 2048 + 1024 + hd * 256, O + r0 * DM + hd * 256, shm);
  }
}

DI void cross_attn_phase(const Params& p, lds_t* shm) {
  const int wid = __builtin_amdgcn_readfirstlane(tidx() >> 6);
  const bf16_t* Q = slot(p, 3); const bf16_t* KV = (const bf16_t*)(p.ws + OFF_KVX); bf16_t* O = slot(p, 0);
  for (int u = blockIdx.x; u < 512; u += gridDim.x) {
    const int bh = u >> 5, qb = u & 31, b = bh >> 2, hd = bh & 3; const size_t r0 = (size_t)b * SEQ + qb * 256 + wid * 32;
    xattn_unit(Q + r0 * DM + hd * 256, KV + (size_t)b * 256 * 2048 + hd * 256, KV + (size_t)b * 256 * 2048 + 1024 + hd * 256, O + r0 * DM + hd * 256, shm);
  }
}

DI void sg_phase(const Params& p, lds_t* shm) {
  const int tid = tidx(), wid = tid >> 6, lane = tid & 63, h = lane >> 5, l31 = lane & 31;
  const bf16_t* Vs = slot(p, 5); bf16_t* U = slot(p, 4); const bf16_t* wm = (const bf16_t*)(p.ws + OFF_WM);
  __attribute__((address_space(3))) float* stats = LDSP(float, shm + 32768);
  const unsigned q4 = (lane & 15) >> 2, pp = lane & 3, blk = (lane >> 4) & 1;
  for (int w = blockIdx.x; w < T_TOK / 128; w += gridDim.x) {
    __syncthreads();
    for (int t4 = 0; t4 < 16; t4 += 4) {
      u32x4 rv[4][2];
#pragma unroll
      for (int q = 0; q < 4; ++q) { const u32x4* rp = (const u32x4*)(Vs + (size_t)(w * 128 + wid * 16 + t4 + q) * DM); rv[q][0] = rp[lane]; rv[q][1] = rp[lane + 64]; }
      float sm[4], sq[4];
#pragma unroll
      for (int q = 0; q < 4; ++q) { float a0 = 0.f, a1 = 0.f;
#pragma unroll
        for (int i = 0; i < 2; ++i)
#pragma unroll
          for (int e = 0; e < 4; ++e) { const float a = bf_lo(rv[q][i][e]), bb = bf_hi(rv[q][i][e]); a0 += a + bb; a1 += a * a + bb * bb; }
        sm[q] = a0; sq[q] = a1; }
#pragma unroll
      for (int q = 0; q < 4; ++q) { sm[q] = wave_sum(sm[q]); sq[q] = wave_sum(sq[q]); }
#pragma unroll
      for (int q = 0; q < 4; ++q) { const int j = wid * 16 + t4 + q; const float mu = sm[q] * (1.0f / DM), var = fmaxf(sq[q] * (1.0f / DM) - mu * mu, 0.f);
        if (lane == 0) { stats[2 * j] = mu; stats[2 * j + 1] = rsqrtf(var + 1e-5f); } }
    }
    u32x4 raw[4];
#pragma unroll
    for (int i = 0; i < 4; ++i) { const int idx = tid + 512 * i, row = idx >> 4, ch = idx & 15; raw[i] = *(const u32x4*)(Vs + (size_t)(w * 128 + row) * DM + ch * 8); }
    for (int g = 0; g < 8; ++g) {
      __syncthreads();
#pragma unroll
      for (int i = 0; i < 4; ++i) {
        const int idx = tid + 512 * i, row = idx >> 4, ch = idx & 15; const int c0 = g * 128 + ch * 8;
        const u32x4 v = raw[i];
        const float mu = stats[2 * row], rs = stats[2 * row + 1];
        const f32x4 g0 = *(const f32x4*)(p.ln_g + c0), g1 = *(const f32x4*)(p.ln_g + c0 + 4), b0 = *(const f32x4*)(p.ln_b + c0), b1 = *(const f32x4*)(p.ln_b + c0 + 4);
        u32x4 o;
        o.x = pk2((bf_lo(v.x) - mu) * rs * g0[0] + b0[0], (bf_hi(v.x) - mu) * rs * g0[1] + b0[1]);
        o.y = pk2((bf_lo(v.y) - mu) * rs * g0[2] + b0[2], (bf_hi(v.y) - mu) * rs * g0[3] + b0[3]);
        o.z = pk2((bf_lo(v.z) - mu) * rs * g1[0] + b1[0], (bf_hi(v.z) - mu) * rs * g1[1] + b1[1]);
        o.w = pk2((bf_lo(v.w) - mu) * rs * g1[2] + b1[2], (bf_hi(v.w) - mu) * rs * g1[3] + b1[3]);
        *LDSP(u32x4, shm + off_a(row, ch)) = o;
      }
      if (g + 1 < 8) {
#pragma unroll
        for (int i = 0; i < 4; ++i) { const int idx = tid + 512 * i, row = idx >> 4, ch = idx & 15; raw[i] = *(const u32x4*)(Vs + (size_t)(w * 128 + row) * DM + (g + 1) * 128 + ch * 8); }
      }
      __syncthreads();
      const int ib = wid & 3, chalf = wid >> 2, nks = (ib < 2) ? 4 : 8;
      f32x16 acc[2];
#pragma unroll
      for (int cc = 0; cc < 2; ++cc)
#pragma unroll
        for (int i = 0; i < 16; ++i) acc[cc][i] = 0.f;
      const bf16_t* wrow = wm + ((size_t)(g * 128 + ib * 32 + l31)) * 128 + 8 * h;
      for (int ks = 0; ks < nks; ++ks) {
        const bf16x8 bfr = *(const bf16x8*)(wrow + 16 * ks);
#pragma unroll
        for (int cc = 0; cc < 2; ++cc) {
          const unsigned chb = 4 * (2 * chalf + cc) + 2 * blk + (pp >> 1);
          const bf16x8 af = tr_pair(shm + off_a(16 * ks + 8 * h + q4, chb) + 8 * (pp & 1), shm + off_a(16 * ks + 8 * h + 4 + q4, chb) + 8 * (pp & 1));
          acc[cc] = MFMA32(af, bfr, acc[cc]);
        }
      }
      const int tok = w * 128 + ib * 32 + l31; const float bias = p.sg_b[g * 128 + ib * 32 + l31];
#pragma unroll
      for (int cc = 0; cc < 2; ++cc)
#pragma unroll
        for (int g4 = 0; g4 < 4; ++g4) {
          bf16_t* up = U + (size_t)tok * DM + g * 128 + 32 * (2 * chalf + cc) + 8 * g4 + 4 * h;
          const u32x2 uu = *(const u32x2*)up; f32x4 o;
          o[0] = bf_lo(uu.x) * (acc[cc][4 * g4 + 0] + bias); o[1] = bf_hi(uu.x) * (acc[cc][4 * g4 + 1] + bias);
          o[2] = bf_lo(uu.y) * (acc[cc][4 * g4 + 2] + bias); o[3] = bf_hi(uu.y) * (acc[cc][4 * g4 + 3] + bias);
          st_bf4(up, o);
        }
    }
  }
}

DI void final_phase(const Params& p) {
  const float* ssq = (const float*)(p.ws + OFF_SSQ) + 2 * T_TOK;
  const int gt = blockIdx.x * NTHR + tidx(), gn = gridDim.x * NTHR;
  for (int i = gt; i < T_TOK * DM / 4; i += gn) {
    const int row = i >> 8, c4 = (i & 255) * 4; const float rs = rsqrtf(ssq[row] * (1.0f / DM) + RMS_EPS);
    f32x4 v = *(f32x4*)(p.out + (size_t)i * 4); v = v * rs * *(const f32x4*)(p.g_final + c4); *(f32x4*)(p.out + (size_t)i * 4) = v;
  }
}


#define XB_TMO      128
#define XB_XCNT(j)  (256  + 64 * (j))
#define XB_XSUB(j)  (1280 + 64 * (j))
#define XB_XGEN(j)  (2304 + 64 * (j))
#define XB_TOP      3328
#define XB_TOPGEN   3392
#define XCD_BAR_WORDS 3456
#define XB_SPIN_CAP (1u << 18)
DI unsigned xb_ld(unsigned* p) { return __hip_atomic_load(p, __ATOMIC_RELAXED, __HIP_MEMORY_SCOPE_AGENT); }
DI unsigned xb_add(unsigned* p, unsigned v) { return __hip_atomic_fetch_add(p, v, __ATOMIC_RELAXED, __HIP_MEMORY_SCOPE_AGENT); }
DI unsigned xb_xcc_id() { return (unsigned)__builtin_amdgcn_s_getreg((3 << 11) | 20) & 0xFu; }
#define XB_SPIN(cond, bar) do { unsigned _sp = 0; while (cond) { __builtin_amdgcn_s_sleep(1); \
    if ((++_sp & 255u) == 0u) { if (xb_ld(&(bar)[XB_TMO])) break; if (_sp > XB_SPIN_CAP) { atomicAdd(&(bar)[XB_TMO], 1u); break; } } } } while (0)
struct XcdBarrier { unsigned* bar; unsigned x, nloc, nx; };
DI unsigned xcd_barrier_post(unsigned* bar) { const unsigned x = xb_xcc_id(); if (threadIdx.x == 0) (void)xb_add(&bar[XB_XCNT(x)], 1u); return x; }
DI void xcd_barrier_complete(unsigned* bar, unsigned x, unsigned& nloc, unsigned& nx) {
  const unsigned G = gridDim.x * gridDim.y * gridDim.z;
  unsigned sum, cnt, mine, sp = 0u;
  for (;;) {
    sum = 0u; cnt = 0u; mine = 0u;
#pragma unroll
    for (unsigned j = 0; j < 16; ++j) { const unsigned c = xb_ld(&bar[XB_XCNT(j)]); sum += c; cnt += (c > 0u) ? 1u : 0u; mine = (j == x) ? c : mine; }
    if (sum == G) break;
    __builtin_amdgcn_s_sleep(1);
    if ((++sp & 255u) == 0u) { if (xb_ld(&bar[XB_TMO])) break; if (sp > XB_SPIN_CAP) { atomicAdd(&bar[XB_TMO], 1u); break; } }
  }
  nloc = mine > 0u ? mine : 1u; nx = cnt > 0u ? cnt : 1u;
}
DI void xcd_barrier(const XcdBarrier& b) {
  asm volatile("s_waitcnt vmcnt(0)" ::: "memory");
  __syncthreads();
  if (threadIdx.x == 0) {
    unsigned* bar = b.bar;
    __builtin_amdgcn_s_waitcnt(0);
    const unsigned nloc = b.nloc, nx = b.nx;
    const unsigned old = xb_add(&bar[XB_XSUB(b.x)], 1u);
    const unsigned gen = old / nloc;
    if (old + 1u == (gen + 1u) * nloc) {
      __builtin_amdgcn_fence(__ATOMIC_RELEASE, "agent");
      asm volatile("s_waitcnt vmcnt(0)" ::: "memory");
      const unsigned og = xb_add(&bar[XB_TOP], 1u);
      const unsigned tg = og / nx;
      if (og + 1u == (tg + 1u) * nx) xb_add(&bar[XB_TOPGEN], 1u);
      else XB_SPIN(xb_ld(&bar[XB_TOPGEN]) == tg, bar);
      __builtin_amdgcn_fence(__ATOMIC_ACQUIRE, "agent");
      xb_add(&bar[XB_XGEN(b.x)], 1u);
      asm volatile("s_waitcnt vmcnt(0)" ::: "memory");
    } else {
      XB_SPIN(xb_ld(&bar[XB_XGEN(b.x)]) == gen, bar);
      __builtin_amdgcn_fence(__ATOMIC_ACQUIRE, "agent");
      asm volatile("s_waitcnt vmcnt(0)" ::: "memory");
    }
  }
  __syncthreads();
}

constexpr int N_PHASES = 12;
template <int PH> DI void run_phase(const Params& p, lds_t* shm) {
  float* ssq = (float*)(p.ws + OFF_SSQ);
  if (PH == 0) prep_phase(p, shm);
  else if (PH == 1) {
    g8::gemm_phase<GSP2, GALIGN>(slot(p, 0), wt(p, W_IN), T_TOK, 7168, 1024, EpiProj{p}, shm);
    g8::gemm_phase<GSP2, GALIGN>((const bf16_t*)(p.ws + OFF_MEMN), wt(p, W_XKV), 1024, 2048, 1024, EpiPlainBf16{(bf16_t*)(p.ws + OFF_KVX), 2048}, shm);
  }
  else if (PH == 2) {}
  else if (PH == 3) { sg_phase(p, shm); diff_attn_phase(p, shm); }
  else if (PH == 4) merged_phase(p, shm);
  else if (PH == 5) g8::gemm_phase<GSP2, GALIGN>(slot(p, 1), wt(p, W_OUT), T_TOK, 1024, 1024, EpiResid{p.x, nullptr, nullptr, slot(p, 2), ssq}, shm);
  else if (PH == 6) { g8::gemm_phase<GSP2, GALIGN>(slot(p, 2), wt(p, W_XQ), T_TOK, 1024, 1024, EpiRowScale{slot(p, 3), 1024, ssq, 0.0625f * LOG2E, 0}, shm); cross_attn_own_tiles(p, shm); }
  else if (PH == 7) {}
  else if (PH == 8) g8::gemm_phase<GSP2, GALIGN>(slot(p, 0), wt(p, W_XO), T_TOK, 1024, 1024, EpiResid{nullptr, slot(p, 2), nullptr, slot(p, 1), ssq + T_TOK}, shm);
  else if (PH == 9) g8::gemm_phase<GSP2, GALIGN>(slot(p, 1), wt(p, W_FF1), T_TOK, 4096, 1024, EpiRowScale{slot(p, 2), 4096, ssq + T_TOK, 1.0f, 1}, shm);
  else if (PH == 10) {
    if (gridDim.x == 256) g8::gemm_phase<GSP2, true>(slot(p, 2), wt(p, W_FF2), T_TOK, 1024, 4096, EpiResidFinal{slot(p, 1), p.out, ssq + 2 * T_TOK, (unsigned*)(p.ws + OFF_BAR) + 3584, p.g_final}, shm);
    else g8::gemm_phase<GSP2, GALIGN>(slot(p, 2), wt(p, W_FF2), T_TOK, 1024, 4096, EpiResid{nullptr, slot(p, 1), p.out, nullptr, ssq + 2 * T_TOK}, shm);
  }
  else if (PH == 11) { if (gridDim.x != 256) final_phase(p); }
}

extern __shared__ __attribute__((aligned(16))) unsigned char smem_raw[];

#if !MK_COOP
template <int PH> __global__ void __launch_bounds__(NTHR) phase_kernel(Params p) { run_phase<PH>(p, (lds_t*)smem_raw); }
template <int PH> static void launch_phases(const Params& p, int grid, hipStream_t stream) {
  (void)hipFuncSetAttribute((const void*)phase_kernel<PH>, hipFuncAttributeMaxDynamicSharedMemorySize, SMEM_BYTES);
  hipLaunchKernelGGL(phase_kernel<PH>, dim3(grid), dim3(NTHR), SMEM_BYTES, stream, p);
  if constexpr (PH + 1 < N_PHASES) launch_phases<PH + 1>(p, grid, stream);
}
#else

template <int PH> DI void run_from(const Params& p, lds_t* shm, cg::grid_group& grid, const XcdBarrier& xb) {
  run_phase<PH>(p, shm);
  if constexpr (PH + 1 < N_PHASES) { if (PH != 2 && PH != 6 && !(PH == 10 && gridDim.x == 256)) xcd_barrier(xb); run_from<PH + 1>(p, shm, grid, xb); }
}
__global__ void __launch_bounds__(NTHR) mega_kernel(Params p) {
  cg::grid_group grid = cg::this_grid();
  if (p.ws == nullptr) grid.sync();
  XcdBarrier xb; xb.bar = (unsigned*)(p.ws + OFF_BAR); xb.x = xcd_barrier_post(xb.bar);
  { __attribute__((address_space(3))) unsigned* t = LDSP(unsigned, smem_raw);
    if (threadIdx.x == 0) { unsigned nloc, nx; xcd_barrier_complete(xb.bar, xb.x, nloc, nx); t[0] = nloc; t[1] = nx; }
    __syncthreads();
    xb.nloc = __builtin_amdgcn_readfirstlane(t[0]); xb.nx = __builtin_amdgcn_readfirstlane(t[1]);
    __syncthreads(); }
  run_from<0>(p, (lds_t*)smem_raw, grid, xb);
}

#endif

extern "C" void kernel_launch(void* const* d_in, const int* in_sizes, int n_in, void* d_out, int out_size, void* d_ws, size_t ws_size, hipStream_t stream) {
  Params p{};
  p.x = (const float*)d_in[0]; p.mem = (const float*)d_in[1]; p.pos = (const int*)d_in[2];
  p.g_mix = (const float*)d_in[3]; p.w_in = (const float*)d_in[4]; p.lq1 = (const float*)d_in[5]; p.lk1 = (const float*)d_in[6]; p.lq2 = (const float*)d_in[7]; p.lk2 = (const float*)d_in[8];
  p.g_subln = (const float*)d_in[9]; p.ln_g = (const float*)d_in[10]; p.ln_b = (const float*)d_in[11]; p.sg_w = (const float*)d_in[12]; p.sg_b = (const float*)d_in[13];
  p.w_ba = (const float*)d_in[14]; p.w_bs = (const float*)d_in[15]; p.w_out = (const float*)d_in[16]; p.g_xa = (const float*)d_in[17]; p.g_mem = (const float*)d_in[18];
  p.w_xq = (const float*)d_in[19]; p.w_xkv = (const float*)d_in[20]; p.w_xo = (const float*)d_in[21]; p.g_ffn = (const float*)d_in[22]; p.w_ff1 = (const float*)d_in[23]; p.w_ff2 = (const float*)d_in[24];
  p.g_final = (const float*)d_in[25]; p.out = (float*)d_out; p.ws = (unsigned char*)d_ws;
#if MK_COOP
  static int grid_blocks = 0;
  if (!grid_blocks) {
    int dev = 0, cus = 0, per_cu = 0; hipGetDevice(&dev); hipDeviceGetAttribute(&cus, hipDeviceAttributeMultiprocessorCount, dev);
    hipFuncSetAttribute((const void*)mega_kernel, hipFuncAttributeMaxDynamicSharedMemorySize, SMEM_BYTES);
    hipOccupancyMaxActiveBlocksPerMultiprocessor(&per_cu, mega_kernel, NTHR, SMEM_BYTES);
    if (per_cu < 1) per_cu = 1;
    grid_blocks = cus * per_cu;
  }
  (void)hipMemsetAsync((char*)d_ws + OFF_BAR, 0, 16384, stream);
  void* args[] = {&p};
  hipError_t e = hipLaunchCooperativeKernel((const void*)mega_kernel, dim3(grid_blocks), dim3(NTHR), args, SMEM_BYTES, stream);
  if (e != hipSuccess) fprintf(stderr, "cooperative launch failed: %s (grid %d)\n", hipGetErrorString(e), grid_blocks);
#else
  launch_phases<0>(p, 256, stream);
#endif
}
```

```cpp
#include <hip/hip_runtime.h>
#include <hip/hip_cooperative_groups.h>
#include <cstdio>
#include <cstdint>
namespace cg = cooperative_groups;

#ifndef MK_COOP
#define MK_COOP 1
#endif

#define DI __device__ __forceinline__
typedef unsigned short bf16_t;
typedef short bf16x8 __attribute__((ext_vector_type(8)));
typedef short s16x4 __attribute__((ext_vector_type(4)));
typedef float f32x2 __attribute__((ext_vector_type(2)));
typedef float f32x4 __attribute__((ext_vector_type(4)));
typedef float f32x16 __attribute__((ext_vector_type(16)));
typedef unsigned u32x2 __attribute__((ext_vector_type(2)));
typedef unsigned u32x4 __attribute__((ext_vector_type(4)));
typedef __bf16 bf2_t __attribute__((ext_vector_type(2)));
typedef __attribute__((address_space(3))) unsigned char lds_t;
#define LDSP(T, p) ((__attribute__((address_space(3))) T*)(p))

constexpr int T_TOK = 32768, SEQ = 8192, DM = 1024, NTHR = 512;
constexpr float RMS_EPS = 1e-6f, LOG2E = 1.4426950408889634f;
constexpr size_t MiB = 1024 * 1024;
constexpr size_t OFF_ROPE = 0, OFF_SSQ = 2 * MiB, OFF_WM = 3 * MiB, OFF_BAR = 3 * MiB + 512 * 1024, OFF_MEMN = 4 * MiB, OFF_KVX = 6 * MiB, OFF_W = 16 * MiB, OFF_SLOT = 64 * MiB, SLOT = 64 * MiB;
constexpr size_t W_IN = 0, W_BA = 14, W_BS = 16, W_OUT = 18, W_XQ = 20, W_XKV = 22, W_XO = 26, W_FF1 = 28, W_FF2 = 36;
constexpr int SMEM_BYTES = 163840;

struct Params {
  const float *x, *mem; const int* pos;
  const float *g_mix, *w_in, *lq1, *lk1, *lq2, *lk2, *g_subln, *ln_g, *ln_b, *sg_w, *sg_b, *w_ba, *w_bs, *w_out, *g_xa, *g_mem, *w_xq, *w_xkv, *w_xo, *g_ffn, *w_ff1, *w_ff2, *g_final;
  float* out; unsigned char* ws;
};

DI int tidx() { int t = threadIdx.x; asm volatile("" : "+v"(t)); return t; }
DI unsigned pk2(float lo, float hi) { bf2_t v = __builtin_convertvector((f32x2){lo, hi}, bf2_t); return __builtin_bit_cast(unsigned, v); }
DI float bf_lo(unsigned u) { return __uint_as_float(u << 16); }
DI float bf_hi(unsigned u) { return __uint_as_float(u & 0xffff0000u); }
DI float wave_sum(float v) {
  v += __shfl_xor(v, 32); v += __shfl_xor(v, 16); v += __shfl_xor(v, 8); v += __shfl_xor(v, 4); v += __shfl_xor(v, 2); v += __shfl_xor(v, 1); return v;
}
template <class T> DI T gld(const void* base, unsigned off) { return *(const T*)((const char*)base + off); }
template <class T> DI void gst(void* base, unsigned off, T v) { *(T*)((char*)base + off) = v; }
DI bf16_t* slot(const Params& p, int i) { return (bf16_t*)(p.ws + OFF_SLOT + (size_t)i * SLOT); }
DI bf16_t* wt(const Params& p, size_t mib) { return (bf16_t*)(p.ws + OFF_W + mib * MiB); }
#define MFMA32(a, b, c) __builtin_amdgcn_mfma_f32_32x32x16_bf16((a), (b), (c), 0, 0, 0)

#ifndef GSP2
#define GSP2 true
#endif
#ifndef GALIGN
#define GALIGN true
#endif
namespace g8 {
constexpr int BM = 256, BK = 64, HALF = 128, HTB = HALF * BK * 2, NXCD = 8, WGM = 8;
typedef f32x4 Acc[2][2][4][2];
DI int lds_byte(int r, int c) { int st = (r >> 4) * 2 + (c >> 5), rr = r & 15, cc = c & 31, ob = rr * 64 + cc * 2; return st * 1024 + (ob ^ (((ob >> 9) & 1) << 5)); }
DI void stage_rc(int b, int& R, int& C) { int st = b / 1024, sb = b % 1024, swz = sb ^ (((sb >> 9) & 1) << 5); R = (st >> 1) * 16 + swz / 64; C = (st & 1) * 32 + (swz % 64) / 2; }

DI int perm32(int rho) { const int n = rho >> 4, i = rho & 15; return 8 * (i >> 2) + 4 * n + (i & 3); }
DI bool tile_coords(int L, int nM, int nN, int& pm, int& pn) {
  const int nwg = nM * nN; if (L >= nwg) return false;
  int wgid = L; { const int q = nwg / NXCD, r = nwg % NXCD, xcd = wgid % NXCD, off = wgid / NXCD; wgid = (xcd < r ? xcd * (q + 1) : r * (q + 1) + (xcd - r) * q) + off; }
  const int nig = WGM * nN, gid = wgid / nig, fm = gid * WGM, gsz = (nM - fm) < WGM ? (nM - fm) : WGM;
  pm = fm + ((wgid % nig) % gsz); pn = (wgid % nig) / gsz; return true;
}

DI void zero_acc(Acc& acc) {
#pragma unroll
  for (int a = 0; a < 2; ++a)
#pragma unroll
    for (int b = 0; b < 2; ++b)
#pragma unroll
      for (int m = 0; m < 4; ++m)
#pragma unroll
        for (int n = 0; n < 2; ++n) acc[a][b][m][n] = (f32x4){0.f, 0.f, 0.f, 0.f};
}

template <class F> DI void epi_loop(Acc& acc, int pm, int pn, int wr, int wc, int fr, int fq, F&& f) {
#pragma unroll
  for (int ai = 0; ai < 2; ++ai)
#pragma unroll
    for (int m = 0; m < 4; ++m) {
      const int row = pm * BM + ai * HALF + wr * 64 + m * 16 + fr;
#pragma unroll
      for (int bj = 0; bj < 2; ++bj) { const int col8 = pn * BM + wc * 64 + bj * 32 + fq * 8; f(row, col8, acc[ai][bj][m][0], acc[ai][bj][m][1]); }
    }
}
DI u32x4 pk8(const f32x4& a, const f32x4& b) { u32x4 w; w.x = pk2(a[0], a[1]); w.y = pk2(a[2], a[3]); w.z = pk2(b[0], b[1]); w.w = pk2(b[2], b[3]); return w; }
template <bool NT = false> DI void st_rows16(void* base, unsigned pitch_b, unsigned row0, unsigned col0, int fr, int fq, const u32x4& w0, const u32x4& w1) {
  u32x4 x;
#pragma unroll
  for (int e = 0; e < 4; ++e) x[e] = (unsigned)__builtin_amdgcn_update_dpp(0, (int)w1[e], 0x128  , 0xf, 0xf, false);
  const bool hi = fr >= 8;
  u32x4 pa, pb;
#pragma unroll
  for (int e = 0; e < 4; ++e) { pa[e] = hi ? x[e] : w0[e]; pb[e] = hi ? w0[e] : x[e]; }
  const unsigned ra = row0 + (unsigned)(fr & 7), ca = col0 + 8u * fq + (hi ? 32u : 0u), cb = col0 + 8u * fq + (hi ? 0u : 32u);
  if (NT) { __builtin_nontemporal_store(pa, (u32x4*)((char*)base + (ra * pitch_b + ca * 2u))); __builtin_nontemporal_store(pb, (u32x4*)((char*)base + ((ra + 8u) * pitch_b + cb * 2u))); }
  else { gst<u32x4>(base, ra * pitch_b + ca * 2u, pa); gst<u32x4>(base, (ra + 8u) * pitch_b + cb * 2u, pb); }
}
DI void unpk8(const u32x4& w, f32x4& a, f32x4& b) { a[0] = bf_lo(w.x); a[1] = bf_hi(w.x); a[2] = bf_lo(w.y); a[3] = bf_hi(w.y); b[0] = bf_lo(w.z); b[1] = bf_hi(w.z); b[2] = bf_lo(w.w); b[3] = bf_hi(w.w); }

template <bool SP2, bool ALIGN_EPI, bool DUAL, class Epi> DI void gemm_phase2(const bf16_t* A, const bf16_t* Bt, const bf16_t* A2, const bf16_t* Bt2, int M, int N, int K, const Epi& E, lds_t* lds) {
  const int nM = M / BM, nN = N / BM, G = gridDim.x, cb = blockIdx.x;
  const int tid = tidx(), wid = __builtin_amdgcn_readfirstlane(tid >> 6), lane = tid & 63, wr = wid >> 2, wc = wid & 3, fr = lane & 15, fq = lane >> 4;
  const int nt = K / BK;
  unsigned voffA[2], voffB[2];
#pragma unroll
  for (int i = 0; i < 2; ++i) { int R, C; stage_rc(tid * 16 + i * 8192, R, C); const int Rb = (R >> 5) * 64 + perm32(R & 31);
    voffA[i] = (unsigned)(R * K + C) * 2u; voffB[i] = (unsigned)(Rb * K + C) * 2u; }
  const size_t kstep = (size_t)(BK * 2), hstep = (size_t)HALF * K * 2, tstep = 2 * hstep, bstep = (size_t)32 * K * 2;
  const unsigned ldsw = (unsigned)wid * 1024u;
  const int aoff = lds_byte(wr * 64 + fr, fq * 8), boff = lds_byte(wc * 32 + fr, fq * 8);
#define SA(b, h) (((b) * 2 + (h)) * HTB)
#define SB(b, h) ((4 + (b) * 2 + (h)) * HTB)
#define STAGE_(bufoff, gbase, voff) do { _Pragma("unroll") for (int _i = 0; _i < 2; ++_i) \
    __builtin_amdgcn_global_load_lds((const __attribute__((address_space(1))) unsigned*)((const char*)(gbase) + voff[_i]), LDSP(unsigned, lds + (bufoff) + ldsw + _i * 8192), 16, 0, 0); } while (0)
#define STAGE(bufoff, gbase) STAGE_(bufoff, gbase, voffA)
#define STAGEB(bufoff, gbase) STAGE_(bufoff, gbase, voffB)
#define LDA(dst, b, h) do { _Pragma("unroll") for (int m = 0; m < 4; ++m) _Pragma("unroll") for (int k = 0; k < 2; ++k) dst[m][k] = *LDSP(const bf16x8, lds + SA(b, h) + aoff + m * 2048 + k * 1024); } while (0)
#define LDB(dst, b, h) do { _Pragma("unroll") for (int n = 0; n < 2; ++n) _Pragma("unroll") for (int k = 0; k < 2; ++k) dst[n][k] = *LDSP(const bf16x8, lds + SB(b, h) + boff + n * 2048 + k * 1024); } while (0)
#define MMA(ai, bj, AT, BT) do { __builtin_amdgcn_s_setprio(1); \
    _Pragma("unroll") for (int m = 0; m < 4; ++m) _Pragma("unroll") for (int n = 0; n < 2; ++n) _Pragma("unroll") for (int k = 0; k < 2; ++k) \
      acc[ai][bj][m][n] = __builtin_amdgcn_mfma_f32_16x16x32_bf16(BT[n][k], AT[m][k], acc[ai][bj][m][n], 0, 0, 0); \
    __builtin_amdgcn_s_setprio(0); } while (0)
#define WAIT_V(n) asm volatile("s_waitcnt vmcnt(" #n ")" ::: "memory")
#define WAIT_L(n) asm volatile("s_waitcnt lgkmcnt(" #n ")" ::: "memory")
#define BAR __builtin_amdgcn_s_barrier()
#define SCHED __builtin_amdgcn_sched_barrier(0)
  int pm, pn, npm = 0, npn = 0, ui = 0, pass = 0;
  if (!tile_coords(cb, nM, nN, pm, pn)) return;
  Acc acc; zero_acc(acc);
  bf16x8 At[4][2], B0[2][2], B1[2][2];
  const char* cA = (const char*)A + (size_t)pm * tstep; const char* cB = (const char*)Bt + (size_t)pn * tstep;
  if constexpr (SP2) {
    STAGEB(SB(0, 0), cB); STAGEB(SB(0, 1), cB + bstep); STAGE(SA(0, 0), cA); STAGE(SA(0, 1), cA + hstep);
    if (wr == 1) BAR;
    WAIT_V(2); BAR;
    STAGEB(SB(1, 0), cB + kstep); STAGE(SA(1, 0), cA + kstep); STAGEB(SB(1, 1), cB + bstep + kstep);
    WAIT_V(6); BAR;
  } else {
    STAGEB(SB(0, 0), cB); STAGE(SA(0, 0), cA); STAGEB(SB(0, 1), cB + bstep); STAGE(SA(0, 1), cA + hstep);
    if (wr == 1) BAR;
    WAIT_V(4); BAR;
    STAGEB(SB(1, 0), cB + kstep); STAGE(SA(1, 0), cA + kstep); STAGEB(SB(1, 1), cB + bstep + kstep);
    WAIT_V(6); BAR;
  }
  for (;;) {
    bool has_next; int npass = 0;
    if (DUAL && pass == 0) { has_next = true; npm = pm; npn = pn; npass = 1; }
    else has_next = tile_coords((ui + 1) * G + cb, nM, nN, npm, npn);
    const char* nAb = (const char*)((DUAL && npass) ? A2 : A); const char* nBb = (const char*)((DUAL && npass) ? Bt2 : Bt);
    const char* nA = has_next ? nAb + (size_t)npm * tstep : cA; const char* nB = has_next ? nBb + (size_t)npn * tstep : cB;
    for (int t = 0; t < nt; t += 2) {
      const bool last = (t == nt - 2);
      const char* a1 = cA + (size_t)(t + 1) * kstep;
      const char* a2 = last ? nA : cA + (size_t)(t + 2) * kstep; const char* b2 = last ? nB : cB + (size_t)(t + 2) * kstep;
      const char* a3 = a2 + kstep; const char* b3 = b2 + kstep;
      if constexpr (SP2) {
        LDB(B0, 0, 0); LDB(B1, 0, 1); SCHED; LDA(At, 0, 0); STAGE(SA(1, 1), a1 + hstep);
        WAIT_V(8); WAIT_L(0); BAR; MMA(0, 0, At, B0); MMA(0, 1, At, B1); BAR; SCHED;
        LDA(At, 0, 1); STAGEB(SB(0, 0), b2); STAGEB(SB(0, 1), b2 + bstep); STAGE(SA(0, 0), a2);
        WAIT_V(8); WAIT_L(0); BAR; MMA(1, 0, At, B0); MMA(1, 1, At, B1); BAR; SCHED;
        LDB(B0, 1, 0); LDB(B1, 1, 1); SCHED; LDA(At, 1, 0); STAGE(SA(0, 1), a2 + hstep);
        WAIT_V(8); WAIT_L(0); BAR; MMA(0, 0, At, B0); MMA(0, 1, At, B1); BAR; SCHED;
        LDA(At, 1, 1); STAGEB(SB(1, 0), b3); STAGEB(SB(1, 1), b3 + bstep); STAGE(SA(1, 0), a3);
        WAIT_V(8); WAIT_L(0); BAR; MMA(1, 0, At, B0); MMA(1, 1, At, B1); BAR; SCHED;
      } else {
        LDB(B0, 0, 0); SCHED; LDA(At, 0, 0); STAGE(SA(1, 1), a1 + hstep);
        WAIT_L(8); BAR; WAIT_L(0); MMA(0, 0, At, B0); BAR; SCHED;
        LDB(B1, 0, 1); STAGEB(SB(0, 0), b2);
        BAR; WAIT_L(0); MMA(0, 1, At, B1); BAR;
        LDA(At, 0, 1); STAGE(SA(0, 0), a2);
        BAR; WAIT_L(0); MMA(1, 0, At, B0); BAR; SCHED;
        STAGEB(SB(0, 1), b2 + bstep);
        WAIT_V(6); BAR; MMA(1, 1, At, B1); BAR;
        LDB(B0, 1, 0); SCHED; LDA(At, 1, 0); STAGE(SA(0, 1), a2 + hstep);
        WAIT_L(8); BAR; WAIT_L(0); MMA(0, 0, At, B0); BAR; SCHED;
        LDB(B1, 1, 1); STAGEB(SB(1, 0), b3);
        BAR; WAIT_L(0); MMA(0, 1, At, B1); BAR;
        LDA(At, 1, 1); STAGE(SA(1, 0), a3);
        BAR; WAIT_L(0); MMA(1, 0, At, B0); BAR; SCHED;
        STAGEB(SB(1, 1), b3 + bstep);
        WAIT_V(6); BAR; MMA(1, 1, At, B1); BAR;
      }
    }
    if constexpr (ALIGN_EPI) { if (wr == 0) BAR; }
    if constexpr (DUAL) { if (pass == 0) E.mid(acc, pm, pn, wr, wc, fr, fq); else E(acc, pm, pn, wr, wc, fr, fq); }
    else E(acc, pm, pn, wr, wc, fr, fq);
    if (!has_next) break;
    if (!(DUAL && pass == 0)) { zero_acc(acc); ++ui; }
    pm = npm; pn = npn; cA = nA; cB = nB; pass = npass;
    if constexpr (ALIGN_EPI) { if (wr == 1) BAR; }
  }
  WAIT_V(0);
  if constexpr (!ALIGN_EPI) { if (wr == 0) BAR; }
  BAR;
#undef SA
#undef SB
#undef STAGE
#undef STAGEB
#undef STAGE_
#undef LDA
#undef LDB
#undef MMA
}
template <bool SP2, bool ALIGN_EPI, class Epi> DI void gemm_phase(const bf16_t* A, const bf16_t* Bt, int M, int N, int K, const Epi& E, lds_t* lds) {
  gemm_phase2<SP2, ALIGN_EPI, false>(A, Bt, nullptr, nullptr, M, N, K, E, lds);
}
}

DI void st_bf4(bf16_t* p, f32x4 v) { u32x2 w; w.x = pk2(v[0], v[1]); w.y = pk2(v[2], v[3]); *(u32x2*)p = w; }

struct EpiProj {
  Params p;
  DI void operator()(g8::Acc& acc, int pm, int pn, int wr, int wc, int fr, int fq) const {
    using namespace g8;
    const int seg = pn >> 2;
    const float* rope = (const float*)(p.ws + OFF_ROPE);
    bf16_t* dst; unsigned ld; int cofs;
    if (seg < 5) { dst = slot(p, seg + 1); ld = 1024; cofs = seg * 1024; } else { dst = (bf16_t*)p.out; ld = 2048; cofs = 5 * 1024; }
    const float qs = (seg == 0) ? 0.125f * LOG2E : 1.0f;
    const float sgn = (fq == 0) ? -1.0f : 1.0f; const bool use = fq < 2;
    const unsigned col0 = (unsigned)(pn * BM + wc * 64 - cofs);
#pragma unroll
    for (int ai = 0; ai < 2; ++ai)
#pragma unroll
      for (int m = 0; m < 4; ++m) {
        const int row0 = pm * BM + ai * HALF + wr * 64 + m * 16, row = row0 + fr;
        u32x4 w[2];
#pragma unroll
        for (int bj = 0; bj < 2; ++bj) {
          f32x4 o0 = acc[ai][bj][m][0], o1 = acc[ai][bj][m][1];
          if (seg < 2) {
            if (bj == 0) {
              const f32x4 c0 = gld<f32x4>(rope, (unsigned)row * 64u), c1 = gld<f32x4>(rope, (unsigned)row * 64u + 16u), s0 = gld<f32x4>(rope, (unsigned)row * 64u + 32u) * sgn, s1 = gld<f32x4>(rope, (unsigned)row * 64u + 48u) * sgn;
              f32x4 p0, p1;
#pragma unroll
              for (int e = 0; e < 4; ++e) { p0[e] = __shfl_xor(o0[e], 16); p1[e] = __shfl_xor(o1[e], 16); }
              const f32x4 r0 = o0 * c0 + p0 * s0, r1 = o1 * c1 + p1 * s1;
#pragma unroll
              for (int e = 0; e < 4; ++e) { o0[e] = use ? r0[e] : o0[e]; o1[e] = use ? r1[e] : o1[e]; }
            }
            o0 = o0 * qs; o1 = o1 * qs;
          } else if (seg == 3 || seg == 4) {
#pragma unroll
            for (int e = 0; e < 4; ++e) {
              { const float xx = o0[e], y2 = (-2.0f * 0.7978845608028654f * LOG2E) * (xx + 0.044715f * xx * xx * xx); o0[e] = xx * __builtin_amdgcn_rcpf(1.0f + __builtin_amdgcn_exp2f(y2)); }
              { const float xx = o1[e], y2 = (-2.0f * 0.7978845608028654f * LOG2E) * (xx + 0.044715f * xx * xx * xx); o1[e] = xx * __builtin_amdgcn_rcpf(1.0f + __builtin_amdgcn_exp2f(y2)); }
            }
          } else if (seg >= 5) {
#pragma unroll
            for (int e = 0; e < 4; ++e) { o0[e] = __builtin_amdgcn_rcpf(1.0f + __builtin_amdgcn_exp2f(-LOG2E * o0[e])); o1[e] = __builtin_amdgcn_rcpf(1.0f + __builtin_amdgcn_exp2f(-LOG2E * o1[e])); }
          }
          w[bj] = pk8(o0, o1);
        }
        st_rows16<true>(dst, ld * 2u, (unsigned)row0, col0, fr, fq, w[0], w[1]);
      }
  }
};

struct EpiPlainBf16 {
  bf16_t* dst; int ld;
  DI void operator()(g8::Acc& acc, int pm, int pn, int wr, int wc, int fr, int fq) const {
    using namespace g8;
#pragma unroll
    for (int ai = 0; ai < 2; ++ai)
#pragma unroll
      for (int m = 0; m < 4; ++m)
        st_rows16(dst, (unsigned)ld * 2u, (unsigned)(pm * BM + ai * HALF + wr * 64 + m * 16), (unsigned)(pn * BM + wc * 64), fr, fq, pk8(acc[ai][0][m][0], acc[ai][0][m][1]), pk8(acc[ai][1][m][0], acc[ai][1][m][1]));
  }
};

struct EpiResid {
  const float* resf; const bf16_t* resb; float* outf; bf16_t* outb; float* ssq;
  DI void operator()(g8::Acc& acc, int pm, int pn, int wr, int wc, int fr, int fq) const {
    using namespace g8;
#pragma unroll
    for (int ai = 0; ai < 2; ++ai)
#pragma unroll
      for (int m = 0; m < 4; ++m) {
        const int row = pm * BM + ai * HALF + wr * 64 + m * 16 + fr; float s = 0.f; u32x4 wv[2];
#pragma unroll
        for (int bj = 0; bj < 2; ++bj) {
          const int col8 = pn * BM + wc * 64 + bj * 32 + fq * 8; const unsigned eo = (unsigned)row * DM + (unsigned)col8;
          f32x4 r0, r1;
          if (resf) { r0 = gld<f32x4>(resf, eo * 4u); r1 = gld<f32x4>(resf, eo * 4u + 16u); }
          else unpk8(gld<u32x4>(resb, eo * 2u), r0, r1);
          const f32x4 o0 = r0 + acc[ai][bj][m][0], o1 = r1 + acc[ai][bj][m][1];
          if (outf) { gst<f32x4>(outf, eo * 4u, o0); gst<f32x4>(outf, eo * 4u + 16u, o1); }
          wv[bj] = pk8(o0, o1);
          s += o0[0] * o0[0] + o0[1] * o0[1] + o0[2] * o0[2] + o0[3] * o0[3] + o1[0] * o1[0] + o1[1] * o1[1] + o1[2] * o1[2] + o1[3] * o1[3];
        }
        if (outb) st_rows16(outb, DM * 2u, (unsigned)(row - fr), (unsigned)(pn * BM + wc * 64), fr, fq, wv[0], wv[1]);
        s += __shfl_xor(s, 16); s += __shfl_xor(s, 32);
        if (fq == 0) atomicAdd(ssq + row, s);
        __builtin_amdgcn_sched_barrier(0);
      }
  }
};

struct EpiResidFinal {
  const bf16_t* resb; float* outf; float* ssq; unsigned* cnt; const float* g;
  DI void operator()(g8::Acc& acc, int pm, int pn, int wr, int wc, int fr, int fq) const {
    using namespace g8;
#pragma unroll
    for (int ai = 0; ai < 2; ++ai)
#pragma unroll
      for (int m = 0; m < 4; ++m) {
        const int row = pm * BM + ai * HALF + wr * 64 + m * 16 + fr; float sq = 0.f;
#pragma unroll
        for (int bj = 0; bj < 2; ++bj) {
          const int col8 = pn * BM + wc * 64 + bj * 32 + fq * 8; const unsigned eo = (unsigned)row * DM + (unsigned)col8;
          f32x4 r0, r1; unpk8(gld<u32x4>(resb, eo * 2u), r0, r1);
          acc[ai][bj][m][0] = acc[ai][bj][m][0] + r0; acc[ai][bj][m][1] = acc[ai][bj][m][1] + r1;
          const f32x4 o0 = acc[ai][bj][m][0], o1 = acc[ai][bj][m][1];
          sq += o0[0] * o0[0] + o0[1] * o0[1] + o0[2] * o0[2] + o0[3] * o0[3] + o1[0] * o1[0] + o1[1] * o1[1] + o1[2] * o1[2] + o1[3] * o1[3];
        }
        sq += __shfl_xor(sq, 16); sq += __shfl_xor(sq, 32);
        if (fq == 0) atomicAdd(ssq + row, sq);
      }
    asm volatile("s_waitcnt vmcnt(0)" ::: "memory");
    __syncthreads();
    if (threadIdx.x == 0) {
      __hip_atomic_fetch_add(cnt + pm, 1u, __ATOMIC_RELAXED, __HIP_MEMORY_SCOPE_AGENT);
      unsigned sp = 0;
      while (__hip_atomic_load(cnt + pm, __ATOMIC_RELAXED, __HIP_MEMORY_SCOPE_AGENT) < 4u) { __builtin_amdgcn_s_sleep(1); if (++sp > (1u << 22)) break; }
    }
    __syncthreads();
#pragma unroll
    for (int ai = 0; ai < 2; ++ai)
#pragma unroll
      for (int m = 0; m < 4; ++m) {
        const int row = pm * BM + ai * HALF + wr * 64 + m * 16 + fr;
        const float rs = rsqrtf(__hip_atomic_load(ssq + row, __ATOMIC_RELAXED, __HIP_MEMORY_SCOPE_AGENT) * (1.0f / DM) + RMS_EPS);
#pragma unroll
        for (int bj = 0; bj < 2; ++bj) {
          const int col8 = pn * BM + wc * 64 + bj * 32 + fq * 8; const unsigned eo = (unsigned)row * DM + (unsigned)col8;
          gst<f32x4>(outf, eo * 4u, acc[ai][bj][m][0] * rs * gld<f32x4>(g, (unsigned)col8 * 4u));
          gst<f32x4>(outf, eo * 4u + 16u, acc[ai][bj][m][1] * rs * gld<f32x4>(g, (unsigned)col8 * 4u + 16u));
        }
      }
  }
};

struct EpiRowScale {
  bf16_t* dst; int ld; const float* ssq; float sc; int act;
  DI void operator()(g8::Acc& acc, int pm, int pn, int wr, int wc, int fr, int fq) const {
    using namespace g8;
#pragma unroll
    for (int ai = 0; ai < 2; ++ai)
#pragma unroll
      for (int m = 0; m < 4; ++m) {
        const int row = pm * BM + ai * HALF + wr * 64 + m * 16 + fr; const float rs = rsqrtf(ssq[row] * (1.0f / DM) + RMS_EPS) * sc;
        u32x4 wv[2];
#pragma unroll
        for (int bj = 0; bj < 2; ++bj) {
          f32x4 o0 = acc[ai][bj][m][0] * rs, o1 = acc[ai][bj][m][1] * rs;
          if (act) {
#pragma unroll
            for (int e = 0; e < 4; ++e) { const float a = fmaxf(o0[e], 0.f), b = fmaxf(o1[e], 0.f); o0[e] = a * a; o1[e] = b * b; } }
          wv[bj] = pk8(o0, o1);
        }
        st_rows16(dst, (unsigned)ld * 2u, (unsigned)(row - fr), (unsigned)(pn * BM + wc * 64), fr, fq, wv[0], wv[1]);
        __builtin_amdgcn_sched_barrier(0);
      }
  }
};

struct EpiGateDual {
  bf16_t* dst; const bf16_t* gates;
  DI void mid(g8::Acc& acc, int pm, int pn, int wr, int wc, int fr, int fq) const {
    using namespace g8;
#pragma unroll
    for (int ai = 0; ai < 2; ++ai)
#pragma unroll
      for (int m = 0; m < 4; ++m) {
        const int row = pm * BM + ai * HALF + wr * 64 + m * 16 + fr;
#pragma unroll
        for (int bj = 0; bj < 2; ++bj) {
          const int col8 = pn * BM + wc * 64 + bj * 32 + fq * 8; const unsigned go = ((unsigned)row * 2048u + (unsigned)col8) * 2u;
          f32x4 a0, a1, s0, s1; unpk8(gld<u32x4>(gates, go), a0, a1); unpk8(gld<u32x4>(gates, go + 2048u), s0, s1);
#pragma unroll
          for (int e = 0; e < 4; ++e) { acc[ai][bj][m][0][e] *= a0[e] * __builtin_amdgcn_rcpf(fmaxf(s0[e], 1e-30f)); acc[ai][bj][m][1][e] *= a1[e] * __builtin_amdgcn_rcpf(fmaxf(s1[e], 1e-30f)); }
        }
        __builtin_amdgcn_sched_barrier(0);
      }
  }
  DI void operator()(g8::Acc& acc, int pm, int pn, int wr, int wc, int fr, int fq) const {
    using namespace g8;
#pragma unroll
    for (int ai = 0; ai < 2; ++ai)
#pragma unroll
      for (int m = 0; m < 4; ++m) {
        const int row0 = pm * BM + ai * HALF + wr * 64 + m * 16, row = row0 + fr; u32x4 wv[2];
#pragma unroll
        for (int bj = 0; bj < 2; ++bj) {
          const int col8 = pn * BM + wc * 64 + bj * 32 + fq * 8; const unsigned go = ((unsigned)row * 2048u + (unsigned)(1024 + col8)) * 2u;
          f32x4 s0, s1; unpk8(gld<u32x4>(gates, go), s0, s1);
#pragma unroll
          for (int e = 0; e < 4; ++e) { s0[e] = fmaxf(s0[e], 1e-30f); s1[e] = fmaxf(s1[e], 1e-30f); }
          wv[bj] = pk8(acc[ai][bj][m][0] * s0, acc[ai][bj][m][1] * s1);
        }
        st_rows16(dst, DM * 2u, (unsigned)row0, (unsigned)(pn * BM + wc * 64), fr, fq, wv[0], wv[1]);
      }
  }
};
DI void merged_phase(const Params& p, lds_t* shm) {
  g8::gemm_phase2<GSP2, GALIGN, true>(slot(p, 0), wt(p, W_BA), slot(p, 4), wt(p, W_BS), T_TOK, DM, DM, EpiGateDual{slot(p, 1), (const bf16_t*)p.out}, shm);
}

DI void wt_transpose(const float* W, bf16_t* Wt, const float* gain, int K, int N, lds_t* shm) {
  const int tk = K / 64, tn = N / 64, tid = tidx();
  __attribute__((address_space(3))) float* tile = LDSP(float, shm);
  for (int t = blockIdx.x; t < tk * tn; t += gridDim.x) {
    const int k0 = (t / tn) * 64, n0 = (t % tn) * 64;
    const int r = tid >> 4, c4 = (tid & 15) * 4;
#pragma unroll
    for (int i = 0; i < 2; ++i) {
      const int kk = r + 32 * i; f32x4 v = __builtin_nontemporal_load((const f32x4*)(W + (size_t)(k0 + kk) * N + n0 + c4));
      if (gain) v = v * gain[k0 + kk];
      tile[kk * 65 + c4 + 0] = v[0]; tile[kk * 65 + c4 + 1] = v[1]; tile[kk * 65 + c4 + 2] = v[2]; tile[kk * 65 + c4 + 3] = v[3];
    }
    __syncthreads();
    const int nn = tid >> 3, k8 = (tid & 7) * 8;
    u32x4 w;
    w.x = pk2(tile[(k8 + 0) * 65 + nn], tile[(k8 + 1) * 65 + nn]); w.y = pk2(tile[(k8 + 2) * 65 + nn], tile[(k8 + 3) * 65 + nn]);
    w.z = pk2(tile[(k8 + 4) * 65 + nn], tile[(k8 + 5) * 65 + nn]); w.w = pk2(tile[(k8 + 6) * 65 + nn], tile[(k8 + 7) * 65 + nn]);
    *(u32x4*)(Wt + (size_t)(n0 + nn) * K + k0 + k8) = w;
    __syncthreads();
  }
}

DI void rms_rows(const float* X, const float* g, bf16_t* out, int nrows) {
  const int wid = tidx() >> 6, lane = tidx() & 63; const int stride = gridDim.x * 8;
  for (int r = blockIdx.x * 8 + wid; r < nrows; r += 2 * stride) {
    const int r2 = r + stride; const bool has2 = r2 < nrows;
    const f32x4* xa = (const f32x4*)(X + (size_t)r * DM); const f32x4* xb = (const f32x4*)(X + (size_t)(has2 ? r2 : r) * DM);
    f32x4 va[4], vb[4]; float sa = 0.f, sb = 0.f;
#pragma unroll
    for (int i = 0; i < 4; ++i) { va[i] = __builtin_nontemporal_load(xa + lane + 64 * i); vb[i] = __builtin_nontemporal_load(xb + lane + 64 * i); }
#pragma unroll
    for (int i = 0; i < 4; ++i) { sa += va[i][0] * va[i][0] + va[i][1] * va[i][1] + va[i][2] * va[i][2] + va[i][3] * va[i][3]; sb += vb[i][0] * vb[i][0] + vb[i][1] * vb[i][1] + vb[i][2] * vb[i][2] + vb[i][3] * vb[i][3]; }
    sa = wave_sum(sa); sb = wave_sum(sb);
    const float ra = rsqrtf(sa * (1.0f / DM) + RMS_EPS), rb = rsqrtf(sb * (1.0f / DM) + RMS_EPS);
#pragma unroll
    for (int i = 0; i < 4; ++i) { const f32x4 gg = ((const f32x4*)g)[lane + 64 * i];
      st_bf4(out + (size_t)r * DM + (lane + 64 * i) * 4, va[i] * ra * gg);
      if (has2) st_bf4(out + (size_t)r2 * DM + (lane + 64 * i) * 4, vb[i] * rb * gg); }
  }
}

DI void prep_phase(const Params& p, lds_t* shm) {
  const int gt = blockIdx.x * NTHR + tidx(), gn = gridDim.x * NTHR;
  float* rope = (float*)(p.ws + OFF_ROPE);
  for (int i = gt; i < T_TOK * 8; i += gn) {
    const int t = i >> 3, f = i & 7; const float inv = (float)exp2(-(double)f * 0.125 * 18.931568569324174  );
    const float ang = (float)p.pos[t] * inv; float s, c; sincosf(ang, &s, &c); rope[t * 16 + f] = c; rope[t * 16 + 8 + f] = s;
  }
  float* ssq = (float*)(p.ws + OFF_SSQ);
  for (int i = gt; i < 3 * T_TOK; i += gn) ssq[i] = 0.f;
  bf16_t* wm = (bf16_t*)(p.ws + OFF_WM);
  for (int i = gt; i < 8 * 128 * 128 / 2; i += gn) {
    const int e = i * 2, ii = (e >> 7) & 127, j = e & 127; const f32x2 w = *(const f32x2*)(p.sg_w + e);
    const bool ok = (j >> 6) <= (ii >> 6); ((unsigned*)wm)[i] = ok ? pk2(w[0], w[1]) : 0u;
  }
  rms_rows(p.x, p.g_mix, slot(p, 0), T_TOK);
  rms_rows(p.mem, p.g_mem, (bf16_t*)(p.ws + OFF_MEMN), 1024);
  wt_transpose(p.w_in, wt(p, W_IN), nullptr, 1024, 7168, shm);
  wt_transpose(p.w_ba, wt(p, W_BA), nullptr, 1024, 1024, shm);
  wt_transpose(p.w_bs, wt(p, W_BS), nullptr, 1024, 1024, shm);
  wt_transpose(p.w_out, wt(p, W_OUT), nullptr, 1024, 1024, shm);
  wt_transpose(p.w_xq, wt(p, W_XQ), p.g_xa, 1024, 1024, shm);
  wt_transpose(p.w_xkv, wt(p, W_XKV), nullptr, 1024, 2048, shm);
  wt_transpose(p.w_xo, wt(p, W_XO), nullptr, 1024, 1024, shm);
  wt_transpose(p.w_ff1, wt(p, W_FF1), p.g_ffn, 1024, 4096, shm);
  wt_transpose(p.w_ff2, wt(p, W_FF2), nullptr, 4096, 1024, shm);
}

DI unsigned off_a(unsigned row, unsigned ch) { return 2048u * (row >> 3) + 512u * (ch >> 2) + 64u * (row & 7) + 16u * ((ch & 3) ^ ((row >> 2) & 3)); }
DI void inv_off_a(unsigned L, unsigned& row, unsigned& ch) {
  const unsigned o = L * 16u, b8 = o >> 11, rem = o & 2047u, chq = rem >> 9, rem2 = rem & 511u, r7 = rem2 >> 6, cx = (rem2 & 63u) >> 4;
  row = b8 * 8 + r7; ch = chq * 4 + (cx ^ ((row >> 2) & 3));
}
DI bf16x8 tr_pair(lds_t* a0, lds_t* a1) {
  const s16x4 lo = __builtin_amdgcn_ds_read_tr16_b64_v4i16(LDSP(s16x4, a0)), hi = __builtin_amdgcn_ds_read_tr16_b64_v4i16(LDSP(s16x4, a1));
  return __builtin_shufflevector(lo, hi, 0, 1, 2, 3, 4, 5, 6, 7);
}

DI void glds16(const void* base, unsigned off, lds_t* dst) {
  __builtin_amdgcn_global_load_lds((const __attribute__((address_space(1))) unsigned*)((const char*)base + off), LDSP(unsigned, dst), 16, 0, 0);
}

DI void dattn_unit2(const bf16_t* __restrict__ Qg, const bf16_t* __restrict__ Kg, const bf16_t* __restrict__ Vg, bf16_t* __restrict__ Og,
                    int ntiles, int wave_tiles, float lam, const float* __restrict__ gsub, lds_t* shm) {
  constexpr int NC = 4, LD = DM;
  constexpr unsigned VRING = 3 * 16384;
  const int tid = tidx(), lane = tid & 63, h = lane >> 5, l31 = lane & 31, wid = __builtin_amdgcn_readfirstlane(tid >> 6), grp = wid >> 2;
  unsigned soff[2];
#pragma unroll
  for (int i = 0; i < 2; ++i) { unsigned r, c; inv_off_a(tid + 512 * i, r, c); soff[i] = (r * (unsigned)LD + c * 8u) * 2u; }
  constexpr unsigned tstep = 64u * LD * 2u;
  const int last_tile = ntiles - 1;
  auto issueK = [&](int kt, int slot) __attribute__((always_inline)) {
    const int t = kt < last_tile ? kt : last_tile; lds_t* base = shm + slot * 16384 + wid * 1024; const char* kb = (const char*)Kg + (size_t)t * tstep;
    glds16(kb, soff[0], base); glds16(kb, soff[1], base + 8192);
  };
  auto issueV = [&](int kt, int slot) __attribute__((always_inline)) {
    const int t = kt < last_tile ? kt : last_tile; lds_t* base = shm + VRING + slot * 16384 + wid * 1024; const char* vb = (const char*)Vg + (size_t)t * tstep;
    glds16(vb, soff[0], base); glds16(vb, soff[1], base + 8192);
  };
#define WAIT_V(n) asm volatile("s_waitcnt vmcnt(" #n ")" ::: "memory")
#define BAR do { __builtin_amdgcn_sched_barrier(0); __builtin_amdgcn_s_barrier(); asm volatile("" ::: "memory"); __builtin_amdgcn_sched_barrier(0); } while (0)
  __syncthreads();
  lds_t* Qst = shm + 6 * 16384 + wid * 8192;
#pragma unroll
  for (int i = 0; i < 8; ++i) { unsigned r, c; inv_off_a(lane + 64 * i, r, c); glds16(Qg, (r * (unsigned)LD + c * 8u) * 2u, Qst + i * 1024); }
  issueK(0, 0); issueV(0, 0); issueK(1, 1); issueV(1, 1);
  f32x16 O[2][NC];
#pragma unroll
  for (int m = 0; m < 2; ++m)
#pragma unroll
    for (int c = 0; c < NC; ++c)
#pragma unroll
      for (int i = 0; i < 16; ++i) O[m][c][i] = 0.f;
  float mrun[2] = {-INFINITY, -INFINITY}, lrun[2] = {0.f, 0.f};
  const unsigned q4 = (lane & 15) >> 2, pp = lane & 3, blk = (lane >> 4) & 1;
  const unsigned xk = (l31 >> 2) & 3, kbase = 2048u * (l31 >> 3) + 64u * (l31 & 7);
  const unsigned ka0 = kbase + 16u * ((unsigned)h ^ xk), ka2 = kbase + 16u * ((2u + h) ^ xk);
  const unsigned vrow = 64u * (4u * h + q4), cl = 2u * blk + (pp >> 1);
  const unsigned va0 = VRING + vrow + 16u * (cl ^ (unsigned)h) + 8u * (pp & 1), va1 = VRING + vrow + 16u * (cl ^ ((unsigned)h ^ 2u)) + 8u * (pp & 1);
  WAIT_V(6); BAR;
  if (grp == 1) { WAIT_V(4); BAR; }
  int slot = 0;
  for (int kt = 0; kt < ntiles; ++kt) {
    const int slot2 = slot >= 1 ? slot - 1 : 2;
    issueK(kt + 2, slot2);
    const float msk = (kt < wave_tiles) ? 0.f : -INFINITY;
    const unsigned so = slot * 16384;
    lds_t* K0 = shm + (so + ka0); lds_t* K2 = shm + (so + ka2);
    bf16x8 P[2][2][2]; float alpha[2]; bool resc[2];
#pragma unroll
    for (int m = 0; m < 2; ++m) {
      f32x16 s[2];
#pragma unroll
      for (int kb = 0; kb < 2; ++kb)
#pragma unroll
        for (int i = 0; i < 16; ++i) s[kb][i] = 0.f;
#pragma unroll
      for (int ss = 0; ss < 4; ++ss) {
        const bf16x8 qv = *LDSP(const bf16x8, Qst + ((ss & 1) ? ka2 : ka0) + 512 * (ss >> 1) + 1024 * m);
#pragma unroll
        for (int kb = 0; kb < 2; ++kb) {
          const bf16x8 kf = *LDSP(const bf16x8, ((ss & 1) ? K2 : K0) + kb * 8192 + 512 * (ss >> 1) + 1024 * m);
          s[kb] = MFMA32(kf, qv, s[kb]);
        }
      }
      float mx = s[0][0];
#pragma unroll
      for (int i = 1; i < 16; ++i) mx = fmaxf(mx, s[0][i]);
#pragma unroll
      for (int i = 0; i < 16; ++i) mx = fmaxf(mx, s[1][i]);
      { const auto sw = __builtin_amdgcn_permlane32_swap(__float_as_uint(mx), __float_as_uint(mx), false, false); mx = fmaxf(__uint_as_float(sw[0]), __uint_as_float(sw[1])) + msk; }
      resc[m] = __builtin_amdgcn_ballot_w64(mx > mrun[m] + 8.0f) != 0;
      alpha[m] = 1.0f;
      if (resc[m]) { const float mnew = fmaxf(mrun[m], mx); alpha[m] = __builtin_amdgcn_exp2f(mrun[m] - mnew); mrun[m] = mnew; lrun[m] *= alpha[m]; }
      const float msub = mrun[m] - msk;
      float rs = 0.f;
#pragma unroll
      for (int kb = 0; kb < 2; ++kb)
#pragma unroll
        for (int s2 = 0; s2 < 2; ++s2) {
          float e[8];
#pragma unroll
          for (int j = 0; j < 8; ++j) { e[j] = __builtin_amdgcn_exp2f(s[kb][8 * s2 + j] - msub); rs += e[j]; }
          u32x4 w; w.x = pk2(e[0], e[1]); w.y = pk2(e[2], e[3]); w.z = pk2(e[4], e[5]); w.w = pk2(e[6], e[7]);
          P[m][kb][s2] = __builtin_bit_cast(bf16x8, w);
          __builtin_amdgcn_sched_barrier(0);
        }
      lrun[m] += rs;
      __builtin_amdgcn_sched_barrier(0);
    }
    __builtin_amdgcn_sched_barrier(0);
    WAIT_V(4); BAR;
    issueV(kt + 2, slot2);
    lds_t* V0 = shm + (so + va0); lds_t* V1 = shm + (so + va1);
#pragma unroll
    for (int m = 0; m < 2; ++m)
      if (resc[m]) {
#pragma unroll
        for (int c = 0; c < NC; ++c) O[m][c] = O[m][c] * alpha[m];
      }
#pragma unroll
    for (int ks = 0; ks < 4; ++ks) {
      bf16x8 vf[NC];
#pragma unroll
      for (int c = 0; c < NC; ++c) { const int vo = 512 * c + 4096 * ks; vf[c] = tr_pair(V0 + vo, V1 + vo + 2048); }
#pragma unroll
      for (int c = 0; c < NC; ++c) { O[0][c] = MFMA32(vf[c], P[0][ks >> 1][ks & 1], O[0][c]); O[1][c] = MFMA32(vf[c], P[1][ks >> 1][ks & 1], O[1][c]); }
    }
    __builtin_amdgcn_sched_barrier(0);
    WAIT_V(4); BAR;
    slot = slot == 2 ? 0 : slot + 1;
  }
  if (grp == 0) BAR;
#undef WAIT_V
#undef BAR
  const float l0 = lrun[0] + __shfl_xor(lrun[0], 32), l1 = lrun[1] + __shfl_xor(lrun[1], 32);
  const float i0 = 1.0f / l0, i1 = lam / l1;
  float ssq = 0.f;
#pragma unroll
  for (int c = 0; c < NC; ++c)
#pragma unroll
    for (int i = 0; i < 16; ++i) { const float a = O[0][c][i] * i0 - O[1][c][i] * i1; O[0][c][i] = a; ssq += a * a; }
  ssq += __shfl_xor(ssq, 32);
  const float inv = rsqrtf(ssq * (1.0f / 128.0f) + RMS_EPS) * 0.8f;
  const int lane_f = tidx() & 63, h_f = lane_f >> 5;
  const unsigned ooff = ((unsigned)(lane_f & 31) * (unsigned)LD + 4u * h_f) * 2u;
#pragma unroll
  for (int c = 0; c < NC; ++c)
#pragma unroll
    for (int g4 = 0; g4 < 4; ++g4) {
      const int dv0 = 32 * c + 8 * g4; f32x4 o;
#pragma unroll
      for (int e = 0; e < 4; ++e) o[e] = O[0][c][4 * g4 + e] * inv;
      o = o * gld<f32x4>(gsub + dv0, 16u * h_f);
      u32x2 w; w.x = pk2(o[0], o[1]); w.y = pk2(o[2], o[3]);
      gst<u32x2>(Og + dv0, ooff, w);
    }
}

DI void diff_attn_phase(const Params& p, lds_t* shm) {
  const int wid = __builtin_amdgcn_readfirstlane(tidx() >> 6), lane = tidx() & 63;
  const float d1 = wave_sum(p.lq1[lane] * p.lk1[lane]), d2 = wave_sum(p.lq2[lane] * p.lk2[lane]);
  const float lam = __uint_as_float(__builtin_amdgcn_readfirstlane(__float_as_uint(expf(d1) - expf(d2) + 0.2f)));
  const bf16_t *Q = slot(p, 1), *K = slot(p, 2), *V = slot(p, 3); bf16_t* A = slot(p, 0);
  const int nit = (gridDim.x == 256) ? 2 : (512 + gridDim.x - 1) / gridDim.x;
  for (int it = 0; it < nit; ++it) {
    int pi;
    if (gridDim.x == 256) { const int x = blockIdx.x & 7, j = blockIdx.x >> 3, t = j + 32 * it; pi = (4 * x + (t >> 4)) * 16 + (t & 15); }
    else { pi = blockIdx.x + it * gridDim.x; if (pi >= 512) break; }
    const int bh = pi >> 4, pp = pi & 15, b = bh >> 3, hd = bh & 7;
    for (int e = 0; e < 2; ++e) {
      const int qb = e ? pp : 31 - pp; const size_t r0 = (size_t)b * SEQ + qb * 256 + wid * 32;
      dattn_unit2(Q + r0 * DM + hd * 128, K + (size_t)b * SEQ * DM + hd * 128, V + (size_t)b * SEQ * DM + hd * 128, A + r0 * DM + hd * 128,
                  qb * 4 + 4, qb * 4 + (wid >> 1) + 1, lam, p.g_subln, shm);
    }
  }
}

DI void xattn_unit(const bf16_t* __restrict__ Qg, const bf16_t* __restrict__ Kg, const bf16_t* __restrict__ Vg, bf16_t* __restrict__ Og, lds_t* shm) {
  constexpr int LDQ = DM, LDKV = 2048, NC = 8;
  const int tid = tidx(), lane = tid & 63, h = lane >> 5, l31 = lane & 31, wid = __builtin_amdgcn_readfirstlane(tid >> 6);
  unsigned soff[2];
#pragma unroll
  for (int i = 0; i < 2; ++i) { unsigned r, c; inv_off_a(tid + 512 * i, r, c); soff[i] = (r * (unsigned)LDKV + c * 8u) * 2u; }
  constexpr unsigned tstep = 64u * LDKV * 2u;
  auto issue_tile = [&](const bf16_t* src, int t, unsigned lds_base) __attribute__((always_inline)) {
    const char* sb = (const char*)src + (size_t)t * tstep; lds_t* base = shm + lds_base + wid * 1024;
#pragma unroll
    for (int im = 0; im < 2; ++im) { glds16(sb + im * 256, soff[0], base + im * 16384); glds16(sb + im * 256, soff[1], base + im * 16384 + 8192); }
  };
  __syncthreads();
#pragma unroll
  for (int t = 0; t < 4; ++t) issue_tile(Kg, t, t * 32768);
  issue_tile(Vg, 0, 131072);
  const unsigned q4 = (lane & 15) >> 2, pp = lane & 3, blk = (lane >> 4) & 1;
  const unsigned xk = (l31 >> 2) & 3, kbase = 2048u * (l31 >> 3) + 64u * (l31 & 7);
  const unsigned ka0 = kbase + 16u * ((unsigned)h ^ xk), ka2 = kbase + 16u * ((2u + h) ^ xk);
  const unsigned vrow = 64u * (4u * h + q4), cl = 2u * blk + (pp >> 1);
  const unsigned va0 = vrow + 16u * (cl ^ (unsigned)h) + 8u * (pp & 1), va1 = vrow + 16u * (cl ^ ((unsigned)h ^ 2u)) + 8u * (pp & 1);
  const unsigned qoff = ((unsigned)l31 * (unsigned)LDQ + 8u * h) * 2u;
  f32x16 S[4][2];
#pragma unroll
  for (int t = 0; t < 4; ++t)
#pragma unroll
    for (int kb = 0; kb < 2; ++kb)
#pragma unroll
      for (int i = 0; i < 16; ++i) S[t][kb][i] = 0.f;
  asm volatile("s_waitcnt vmcnt(0)" ::: "memory");
  __syncthreads();
  __builtin_amdgcn_sched_barrier(0);
#pragma unroll
  for (int ss = 0; ss < 16; ++ss) {
    const int cgl = 2 * ss, img = cgl >> 4;
    const bf16x8 qv = gld<bf16x8>(Qg + 16 * ss, qoff);
#pragma unroll
    for (int t = 0; t < 4; ++t)
#pragma unroll
      for (int kb = 0; kb < 2; ++kb) {
        const bf16x8 kf = *LDSP(const bf16x8, shm + t * 32768 + img * 16384 + kb * 8192 + 512 * ((cgl & 15) >> 2) + ((cgl & 2) ? ka2 : ka0));
        S[t][kb] = MFMA32(kf, qv, S[t][kb]);
      }
  }
  float mx = S[0][0][0];
#pragma unroll
  for (int t = 0; t < 4; ++t)
#pragma unroll
    for (int kb = 0; kb < 2; ++kb)
#pragma unroll
      for (int i = 0; i < 16; ++i) mx = fmaxf(mx, S[t][kb][i]);
  { const auto sw = __builtin_amdgcn_permlane32_swap(__float_as_uint(mx), __float_as_uint(mx), false, false); mx = fmaxf(__uint_as_float(sw[0]), __uint_as_float(sw[1])); }
  float rs = 0.f;
  bf16x8 P[4][2][2];
#pragma unroll
  for (int t = 0; t < 4; ++t)
#pragma unroll
    for (int kb = 0; kb < 2; ++kb)
#pragma unroll
      for (int s2 = 0; s2 < 2; ++s2) {
        float e[8];
#pragma unroll
        for (int j = 0; j < 8; ++j) { e[j] = __builtin_amdgcn_exp2f(S[t][kb][8 * s2 + j] - mx); rs += e[j]; }
        u32x4 w; w.x = pk2(e[0], e[1]); w.y = pk2(e[2], e[3]); w.z = pk2(e[4], e[5]); w.w = pk2(e[6], e[7]);
        P[t][kb][s2] = __builtin_bit_cast(bf16x8, w);
      }
  const float l = rs + __shfl_xor(rs, 32);
  __builtin_amdgcn_sched_barrier(0);
  __syncthreads();
  __builtin_amdgcn_sched_barrier(0);
#pragma unroll
  for (int t = 1; t < 4; ++t) issue_tile(Vg, t, t * 32768);
  f32x16 O[NC];
#pragma unroll
  for (int c = 0; c < NC; ++c)
#pragma unroll
    for (int i = 0; i < 16; ++i) O[c][i] = 0.f;
#pragma unroll
  for (int t = 0; t < 4; ++t) {
    if (t == 1) { __builtin_amdgcn_sched_barrier(0); asm volatile("s_waitcnt vmcnt(0)" ::: "memory"); __syncthreads(); __builtin_amdgcn_sched_barrier(0); }
    const unsigned vbase = (t == 0) ? 131072u : (unsigned)t * 32768u;
#pragma unroll
    for (int ks = 0; ks < 4; ++ks)
#pragma unroll
      for (int c = 0; c < NC; ++c) {
        const unsigned vo = vbase + (c >> 2) * 16384 + 512 * (c & 3) + 4096 * ks;
        const bf16x8 vf = tr_pair(shm + vo + va0, shm + vo + 2048 + va1);
        O[c] = MFMA32(vf, P[t][ks >> 1][ks & 1], O[c]);
      }
  }
  const float inv = 1.0f / l;
  const unsigned ooff = ((unsigned)l31 * (unsigned)LDQ + 4u * h) * 2u;
#pragma unroll
  for (int c = 0; c < NC; ++c)
#pragma unroll
    for (int g4 = 0; g4 < 4; ++g4) {
      u32x2 w; w.x = pk2(O[c][4 * g4 + 0] * inv, O[c][4 * g4 + 1] * inv); w.y = pk2(O[c][4 * g4 + 2] * inv, O[c][4 * g4 + 3] * inv);
      gst<u32x2>(Og + 32 * c + 8 * g4, ooff, w);
    }
}

DI void cross_attn_own_tiles(const Params& p, lds_t* shm) {
  const int wid = __builtin_amdgcn_readfirstlane(tidx() >> 6);
  const bf16_t* Q = slot(p, 3); const bf16_t* KV = (const bf16_t*)(p.ws + OFF_KVX); bf16_t* O = slot(p, 0);
  for (int i = 0;; ++i) {
    int pm, pn; if (!g8::tile_coords(i * (int)gridDim.x + (int)blockIdx.x, T_TOK / 256, 4, pm, pn)) break;
    const int b = pm >> 5, hd = pn; const size_t r0 = (size_t)pm * 256 + wid * 32;
    xattn_unit(Q + r0 * DM + hd * 256, KV + (size_t)b * 256 * 2048 + hd * 256, KV + (size_t)b * 256 * 2048 + 1024 + hd * 256, O + r0 * DM + hd * 256, shm);
  }
}

DI void cross_attn_phase(const Params& p, lds_t* shm) {
  const int wid = __builtin_amdgcn_readfirstlane(tidx() >> 6);
  const bf16_t* Q = slot(p, 3); const bf16_t* KV = (const bf16_t*)(p.ws + OFF_KVX); bf16_t* O = slot(p, 0);
  for (int u = blockIdx.x; u < 512; u += gridDim.x) {
    const int bh = u >> 5, qb = u & 31, b = bh >> 2, hd = bh & 3; const size_t r0 = (size_t)b * SEQ + qb * 256 + wid * 32;
    xattn_unit(Q + r0 * DM + hd * 256, KV + (size_t)b * 256 * 2048 + hd * 256, KV + (size_t)b * 256 * 2048 + 1024 + hd * 256, O + r0 * DM + hd * 256, shm);
  }
}

DI void sg_phase(const Params& p, lds_t* shm) {
  const int tid = tidx(), wid = tid >> 6, lane = tid & 63, h = lane >> 5, l31 = lane & 31;
  const bf16_t* Vs = slot(p, 5); bf16_t* U = slot(p, 4); const bf16_t* wm = (const bf16_t*)(p.ws + OFF_WM);
  __attribute__((address_space(3))) float* stats = LDSP(float, shm + 32768);
  const unsigned q4 = (lane & 15) >> 2, pp = lane & 3, blk = (lane >> 4) & 1;
  for (int w = blockIdx.x; w < T_TOK / 128; w += gridDim.x) {
    __syncthreads();
    for (int t4 = 0; t4 < 16; t4 += 4) {
      u32x4 rv[4][2];
#pragma unroll
      for (int q = 0; q < 4; ++q) { const u32x4* rp = (const u32x4*)(Vs + (size_t)(w * 128 + wid * 16 + t4 + q) * DM); rv[q][0] = rp[lane]; rv[q][1] = rp[lane + 64]; }
      float sm[4], sq[4];
#pragma unroll
      for (int q = 0; q < 4; ++q) { float a0 = 0.f, a1 = 0.f;
#pragma unroll
        for (int i = 0; i < 2; ++i)
#pragma unroll
          for (int e = 0; e < 4; ++e) { const float a = bf_lo(rv[q][i][e]), bb = bf_hi(rv[q][i][e]); a0 += a + bb; a1 += a * a + bb * bb; }
        sm[q] = a0; sq[q] = a1; }
#pragma unroll
      for (int q = 0; q < 4; ++q) { sm[q] = wave_sum(sm[q]); sq[q] = wave_sum(sq[q]); }
#pragma unroll
      for (int q = 0; q < 4; ++q) { const int j = wid * 16 + t4 + q; const float mu = sm[q] * (1.0f / DM), var = fmaxf(sq[q] * (1.0f / DM) - mu * mu, 0.f);
        if (lane == 0) { stats[2 * j] = mu; stats[2 * j + 1] = rsqrtf(var + 1e-5f); } }
    }
    u32x4 raw[4];
#pragma unroll
    for (int i = 0; i < 4; ++i) { const int idx = tid + 512 * i, row = idx >> 4, ch = idx & 15; raw[i] = *(const u32x4*)(Vs + (size_t)(w * 128 + row) * DM + ch * 8); }
    for (int g = 0; g < 8; ++g) {
      __syncthreads();
#pragma unroll
      for (int i = 0; i < 4; ++i) {
        const int idx = tid + 512 * i, row = idx >> 4, ch = idx & 15; const int c0 = g * 128 + ch * 8;
        const u32x4 v = raw[i];
        const float mu = stats[2 * row], rs = stats[2 * row + 1];
        const f32x4 g0 = *(const f32x4*)(p.ln_g + c0), g1 = *(const f32x4*)(p.ln_g + c0 + 4), b0 = *(const f32x4*)(p.ln_b + c0), b1 = *(const f32x4*)(p.ln_b + c0 + 4);
        u32x4 o;
        o.x = pk2((bf_lo(v.x) - mu) * rs * g0[0] + b0[0], (bf_hi(v.x) - mu) * rs * g0[1] + b0[1]);
        o.y = pk2((bf_lo(v.y) - mu) * rs * g0[2] + b0[2], (bf_hi(v.y) - mu) * rs * g0[3] + b0[3]);
        o.z = pk2((bf_lo(v.z) - mu) * rs * g1[0] + b1[0], (bf_hi(v.z) - mu) * rs * g1[1] + b1[1]);
        o.w = pk2((bf_lo(v.w) - mu) * rs * g1[2] + b1[2], (bf_hi(v.w) - mu) * rs * g1[3] + b1[3]);
        *LDSP(u32x4, shm + off_a(row, ch)) = o;
      }
      if (g + 1 < 8) {
#pragma unroll
        for (int i = 0; i < 4; ++i) { const int idx = tid + 512 * i, row = idx >> 4, ch = idx & 15; raw[i] = *(const u32x4*)(Vs + (size_t)(w * 128 + row) * DM + (g + 1) * 128 + ch * 8); }
      }
      __syncthreads();
      const int ib = wid & 3, chalf = wid >> 2, nks = (ib < 2) ? 4 : 8;
      f32x16 acc[2];
#pragma unroll
      for (int cc = 0; cc < 2; ++cc)
#pragma unroll
        for (int i = 0; i < 16; ++i) acc[cc][i] = 0.f;
      const bf16_t* wrow = wm + ((size_t)(g * 128 + ib * 32 + l31)) * 128 + 8 * h;
      for (int ks = 0; ks < nks; ++ks) {
        const bf16x8 bfr = *(const bf16x8*)(wrow + 16 * ks);
#pragma unroll
        for (int cc = 0; cc < 2; ++cc) {
          const unsigned chb = 4 * (2 * chalf + cc) + 2 * blk + (pp >> 1);
          const bf16x8 af = tr_pair(shm + off_a(16 * ks + 8 * h + q4, chb) + 8 * (pp & 1), shm + off_a(16 * ks + 8 * h + 4 + q4, chb) + 8 * (pp & 1));
          acc[cc] = MFMA32(af, bfr, acc[cc]);
        }
      }
      const int tok = w * 128 + ib * 32 + l31; const float bias = p.sg_b[g * 128 + ib * 32 + l31];
#pragma unroll
      for (int cc = 0; cc < 2; ++cc)
#pragma unroll
        for (int g4 = 0; g4 < 4; ++g4) {
          bf16_t* up = U + (size_t)tok * DM + g * 128 + 32 * (2 * chalf + cc) + 8 * g4 + 4 * h;
          const u32x2 uu = *(const u32x2*)up; f32x4 o;
          o[0] = bf_lo(uu.x) * (acc[cc][4 * g4 + 0] + bias); o[1] = bf_hi(uu.x) * (acc[cc][4 * g4 + 1] + bias);
          o[2] = bf_lo(uu.y) * (acc[cc][4 * g4 + 2] + bias); o[3] = bf_hi(uu.y) * (acc[cc][4 * g4 + 3] + bias);
          st_bf4(up, o);
        }
    }
  }
}

DI void final_phase(const Params& p) {
  const float* ssq = (const float*)(p.ws + OFF_SSQ) + 2 * T_TOK;
  const int gt = blockIdx.x * NTHR + tidx(), gn = gridDim.x * NTHR;
  for (int i = gt; i < T_TOK * DM / 4; i += gn) {
    const int row = i >> 8, c4 = (i & 255) * 4; const float rs = rsqrtf(ssq[row] * (1.0f / DM) + RMS_EPS);
    f32x4 v = *(f32x4*)(p.out + (size_t)i * 4); v = v * rs * *(const f32x4*)(p.g_final + c4); *(f32x4*)(p.out + (size_t)i * 4) = v;
  }
}


#define XB_TMO      128
#define XB_XCNT(j)  (256  + 64 * (j))
#define XB_XSUB(j)  (1280 + 64 * (j))
#define XB_XGEN(j)  (2304 + 64 * (j))
#define XB_TOP      3328
#define XB_TOPGEN   3392
#define XCD_BAR_WORDS 3456
#define XB_SPIN_CAP (1u << 18)
DI unsigned xb_ld(unsigned* p) { return __hip_atomic_load(p, __ATOMIC_RELAXED, __HIP_MEMORY_SCOPE_AGENT); }
DI unsigned xb_add(unsigned* p, unsigned v) { return __hip_atomic_fetch_add(p, v, __ATOMIC_RELAXED, __HIP_MEMORY_SCOPE_AGENT); }
DI unsigned xb_xcc_id() { return (unsigned)__builtin_amdgcn_s_getreg((3 << 11) | 20) & 0xFu; }
#define XB_SPIN(cond, bar) do { unsigned _sp = 0; while (cond) { __builtin_amdgcn_s_sleep(1); \
    if ((++_sp & 255u) == 0u) { if (xb_ld(&(bar)[XB_TMO])) break; if (_sp > XB_SPIN_CAP) { atomicAdd(&(bar)[XB_TMO], 1u); break; } } } } while (0)
struct XcdBarrier { unsigned* bar; unsigned x, nloc, nx; };
DI unsigned xcd_barrier_post(unsigned* bar) { const unsigned x = xb_xcc_id(); if (threadIdx.x == 0) (void)xb_add(&bar[XB_XCNT(x)], 1u); return x; }
DI void xcd_barrier_complete(unsigned* bar, unsigned x, unsigned& nloc, unsigned& nx) {
  const unsigned G = gridDim.x * gridDim.y * gridDim.z;
  unsigned sum, cnt, mine, sp = 0u;
  for (;;) {
    sum = 0u; cnt = 0u; mine = 0u;
#pragma unroll
    for (unsigned j = 0; j < 16; ++j) { const unsigned c = xb_ld(&bar[XB_XCNT(j)]); sum += c; cnt += (c > 0u) ? 1u : 0u; mine = (j == x) ? c : mine; }
    if (sum == G) break;
    __builtin_amdgcn_s_sleep(1);
    if ((++sp & 255u) == 0u) { if (xb_ld(&bar[XB_TMO])) break; if (sp > XB_SPIN_CAP) { atomicAdd(&bar[XB_TMO], 1u); break; } }
  }
  nloc = mine > 0u ? mine : 1u; nx = cnt > 0u ? cnt : 1u;
}
DI void xcd_barrier(const XcdBarrier& b) {
  asm volatile("s_waitcnt vmcnt(0)" ::: "memory");
  __syncthreads();
  if (threadIdx.x == 0) {
    unsigned* bar = b.bar;
    __builtin_amdgcn_s_waitcnt(0);
    const unsigned nloc = b.nloc, nx = b.nx;
    const unsigned old = xb_add(&bar[XB_XSUB(b.x)], 1u);
    const unsigned gen = old / nloc;
    if (old + 1u == (gen + 1u) * nloc) {
      __builtin_amdgcn_fence(__ATOMIC_RELEASE, "agent");
      asm volatile("s_waitcnt vmcnt(0)" ::: "memory");
      const unsigned og = xb_add(&bar[XB_TOP], 1u);
      const unsigned tg = og / nx;
      if (og + 1u == (tg + 1u) * nx) xb_add(&bar[XB_TOPGEN], 1u);
      else XB_SPIN(xb_ld(&bar[XB_TOPGEN]) == tg, bar);
      __builtin_amdgcn_fence(__ATOMIC_ACQUIRE, "agent");
      xb_add(&bar[XB_XGEN(b.x)], 1u);
      asm volatile("s_waitcnt vmcnt(0)" ::: "memory");
    } else {
      XB_SPIN(xb_ld(&bar[XB_XGEN(b.x)]) == gen, bar);
      __builtin_amdgcn_fence(__ATOMIC_ACQUIRE, "agent");
      asm volatile("s_waitcnt vmcnt(0)" ::: "memory");
    }
  }
  __syncthreads();
}

constexpr int N_PHASES = 12;
template <int PH> DI void run_phase(const Params& p, lds_t* shm) {
  float* ssq = (float*)(p.ws + OFF_SSQ);
  if (PH == 0) prep_phase(p, shm);
  else if (PH == 1) {
    g8::gemm_phase<GSP2, GALIGN>(slot(p, 0), wt(p, W_IN), T_TOK, 7168, 1024, EpiProj{p}, shm);
    g8::gemm_phase<GSP2, GALIGN>((const bf16_t*)(p.ws + OFF_MEMN), wt(p, W_XKV), 1024, 2048, 1024, EpiPlainBf16{(bf16_t*)(p.ws + OFF_KVX), 2048}, shm);
  }
  else if (PH == 2) {}
  else if (PH == 3) { sg_phase(p, shm); diff_attn_phase(p, shm); }
  else if (PH == 4) merged_phase(p, shm);
  else if (PH == 5) g8::gemm_phase<GSP2, GALIGN>(slot(p, 1), wt(p, W_OUT), T_TOK, 1024, 1024, EpiResid{p.x, nullptr, nullptr, slot(p, 2), ssq}, shm);
  else if (PH == 6) { g8::gemm_phase<GSP2, GALIGN>(slot(p, 2), wt(p, W_XQ), T_TOK, 1024, 1024, EpiRowScale{slot(p, 3), 1024, ssq, 0.0625f * LOG2E, 0}, shm); cross_attn_own_tiles(p, shm); }
  else if (PH == 7) {}
  else if (PH == 8) g8::gemm_phase<GSP2, GALIGN>(slot(p, 0), wt(p, W_XO), T_TOK, 1024, 1024, EpiResid{nullptr, slot(p, 2), nullptr, slot(p, 1), ssq + T_TOK}, shm);
  else if (PH == 9) g8::gemm_phase<GSP2, GALIGN>(slot(p, 1), wt(p, W_FF1), T_TOK, 4096, 1024, EpiRowScale{slot(p, 2), 4096, ssq + T_TOK, 1.0f, 1}, shm);
  else if (PH == 10) {
    if (gridDim.x == 256) g8::gemm_phase<GSP2, true>(slot(p, 2), wt(p, W_FF2), T_TOK, 1024, 4096, EpiResidFinal{slot(p, 1), p.out, ssq + 2 * T_TOK, (unsigned*)(p.ws + OFF_BAR) + 3584, p.g_final}, shm);
    else g8::gemm_phase<GSP2, GALIGN>(slot(p, 2), wt(p, W_FF2), T_TOK, 1024, 4096, EpiResid{nullptr, slot(p, 1), p.out, nullptr, ssq + 2 * T_TOK}, shm);
  }
  else if (PH == 11) { if (gridDim.x != 256) final_phase(p); }
}

extern __shared__ __attribute__((aligned(16))) unsigned char smem_raw[];

#if !MK_COOP
template <int PH> __global__ void __launch_bounds__(NTHR) phase_kernel(Params p) { run_phase<PH>(p, (lds_t*)smem_raw); }
template <int PH> static void launch_phases(const Params& p, int grid, hipStream_t stream) {
  (void)hipFuncSetAttribute((const void*)phase_kernel<PH>, hipFuncAttributeMaxDynamicSharedMemorySize, SMEM_BYTES);
  hipLaunchKernelGGL(phase_kernel<PH>, dim3(grid), dim3(NTHR), SMEM_BYTES, stream, p);
  if constexpr (PH + 1 < N_PHASES) launch_phases<PH + 1>(p, grid, stream);
}
#else

template <int PH> DI void run_from(const Params& p, lds_t* shm, cg::grid_group& grid, const XcdBarrier& xb) {
  run_phase<PH>(p, shm);
  if constexpr (PH + 1 < N_PHASES) { if (PH != 2 && PH != 6 && !(PH == 10 && gridDim.x == 256)) xcd_barrier(xb); run_from<PH + 1>(p, shm, grid, xb); }
}
__global__ void __launch_bounds__(NTHR) mega_kernel(Params p) {
  cg::grid_group grid = cg::this_grid();
  if (p.ws == nullptr) grid.sync();
  XcdBarrier xb; xb.bar = (unsigned*)(p.ws + OFF_BAR); xb.x = xcd_barrier_post(xb.bar);
  { __attribute__((address_space(3))) unsigned* t = LDSP(unsigned, smem_raw);
    if (threadIdx.x == 0) { unsigned nloc, nx; xcd_barrier_complete(xb.bar, xb.x, nloc, nx); t[0] = nloc; t[1] = nx; }
    __syncthreads();
    xb.nloc = __builtin_amdgcn_readfirstlane(t[0]); xb.nx = __builtin_amdgcn_readfirstlane(t[1]);
    __syncthreads(); }
  run_from<0>(p, (lds_t*)smem_raw, grid, xb);
}

#endif

extern "C" void kernel_launch(void* const* d_in, const int* in_sizes, int n_in, void* d_out, int out_size, void* d_ws, size_t ws_size, hipStream_t stream) {
  Params p{};
  p.x = (const float*)d_in[0]; p.mem = (const float*)d_in[1]; p.pos = (const int*)d_in[2];
  p.g_mix = (const float*)d_in[3]; p.w_in = (const float*)d_in[4]; p.lq1 = (const float*)d_in[5]; p.lk1 = (const float*)d_in[6]; p.lq2 = (const float*)d_in[7]; p.lk2 = (const float*)d_in[8];
  p.g_subln = (const float*)d_in[9]; p.ln_g = (const float*)d_in[10]; p.ln_b = (const float*)d_in[11]; p.sg_w = (const float*)d_in[12]; p.sg_b = (const float*)d_in[13];
  p.w_ba = (const float*)d_in[14]; p.w_bs = (const float*)d_in[15]; p.w_out = (const float*)d_in[16]; p.g_xa = (const float*)d_in[17]; p.g_mem = (const float*)d_in[18];
  p.w_xq = (const float*)d_in[19]; p.w_xkv = (const float*)d_in[20]; p.w_xo = (const float*)d_in[21]; p.g_ffn = (const float*)d_in[22]; p.w_ff1 = (const float*)d_in[23]; p.w_ff2 = (const float*)d_in[24];
  p.g_final = (const float*)d_in[25]; p.out = (float*)d_out; p.ws = (unsigned char*)d_ws;
#if MK_COOP
  static int grid_blocks = 0;
  if (!grid_blocks) {
    int dev = 0, cus = 0, per_cu = 0; hipGetDevice(&dev); hipDeviceGetAttribute(&cus, hipDeviceAttributeMultiprocessorCount, dev);
    hipFuncSetAttribute((const void*)mega_kernel, hipFuncAttributeMaxDynamicSharedMemorySize, SMEM_BYTES);
    hipOccupancyMaxActiveBlocksPerMultiprocessor(&per_cu, mega_kernel, NTHR, SMEM_BYTES);
    if (per_cu < 1) per_cu = 1;
    grid_blocks = cus * per_cu;
  }
  (void)hipMemsetAsync((char*)d_ws + OFF_BAR, 0, 16384, stream);
  void* args[] = {&p};
  hipError_t e = hipLaunchCooperativeKernel((const void*)mega_kernel, dim3(grid_blocks), dim3(NTHR), args, SMEM_BYTES, stream);
  if (e != hipSuccess) fprintf(stderr, "cooperative launch failed: %s (grid %d)\n", hipGetErrorString(e), grid_blocks);
#else
  launch_phases<0>(p, 256, stream);
#endif
}
```

```cpp
#include <hip/hip_runtime.h>
#include <hip/hip_cooperative_groups.h>
#include <cstdio>
#include <cstdint>
namespace cg = cooperative_groups;

#ifndef MK_COOP
#define MK_COOP 1
#endif

#define DI __device__ __forceinline__
typedef unsigned short bf16_t;
typedef short bf16x8 __attribute__((ext_vector_type(8)));
typedef short s16x4 __attribute__((ext_vector_type(4)));
typedef float f32x2 __attribute__((ext_vector_type(2)));
typedef float f32x4 __attribute__((ext_vector_type(4)));
typedef float f32x16 __attribute__((ext_vector_type(16)));
typedef unsigned u32x2 __attribute__((ext_vector_type(2)));
typedef unsigned u32x4 __attribute__((ext_vector_type(4)));
typedef __bf16 bf2_t __attribute__((ext_vector_type(2)));
typedef __attribute__((address_space(3))) unsigned char lds_t;
#define LDSP(T, p) ((__attribute__((address_space(3))) T*)(p))

constexpr int T_TOK = 32768, SEQ = 8192, DM = 1024, NTHR = 512;
constexpr float RMS_EPS = 1e-6f, LOG2E = 1.4426950408889634f;
constexpr size_t MiB = 1024 * 1024;
constexpr size_t OFF_ROPE = 0, OFF_SSQ = 2 * MiB, OFF_WM = 3 * MiB, OFF_BAR = 3 * MiB + 512 * 1024, OFF_MEMN = 4 * MiB, OFF_KVX = 6 * MiB, OFF_W = 16 * MiB, OFF_SLOT = 64 * MiB, SLOT = 64 * MiB;
constexpr size_t W_IN = 0, W_BA = 14, W_BS = 16, W_OUT = 18, W_XQ = 20, W_XKV = 22, W_XO = 26, W_FF1 = 28, W_FF2 = 36;
constexpr int SMEM_BYTES = 163840;

struct Params {
  const float *x, *mem; const int* pos;
  const float *g_mix, *w_in, *lq1, *lk1, *lq2, *lk2, *g_subln, *ln_g, *ln_b, *sg_w, *sg_b, *w_ba, *w_bs, *w_out, *g_xa, *g_mem, *w_xq, *w_xkv, *w_xo, *g_ffn, *w_ff1, *w_ff2, *g_final;
  float* out; unsigned char* ws;
};

DI int tidx() { int t = threadIdx.x; asm volatile("" : "+v"(t)); return t; }
DI unsigned pk2(float lo, float hi) { bf2_t v = __builtin_convertvector((f32x2){lo, hi}, bf2_t); return __builtin_bit_cast(unsigned, v); }
DI float bf_lo(unsigned u) { return __uint_as_float(u << 16); }
DI float bf_hi(unsigned u) { return __uint_as_float(u & 0xffff0000u); }
DI float wave_sum(float v) {
  v += __shfl_xor(v, 32); v += __shfl_xor(v, 16); v += __shfl_xor(v, 8); v += __shfl_xor(v, 4); v += __shfl_xor(v, 2); v += __shfl_xor(v, 1); return v;
}
template <class T> DI T gld(const void* base, unsigned off) { return *(const T*)((const char*)base + off); }
template <class T> DI T gld_nt(const void* base, unsigned off) { return __builtin_nontemporal_load((const T*)((const char*)base + off)); }
template <class T> DI void gst(void* base, unsigned off, T v) { *(T*)((char*)base + off) = v; }
DI bf16_t* slot(const Params& p, int i) { return (bf16_t*)(p.ws + OFF_SLOT + (size_t)i * SLOT); }
DI bf16_t* wt(const Params& p, size_t mib) { return (bf16_t*)(p.ws + OFF_W + mib * MiB); }
#define MFMA32(a, b, c) __builtin_amdgcn_mfma_f32_32x32x16_bf16((a), (b), (c), 0, 0, 0)

#ifndef GSP2
#define GSP2 true
#endif
#ifndef GALIGN
#define GALIGN true
#endif
namespace g8 {
constexpr int BM = 256, BK = 64, HALF = 128, HTB = HALF * BK * 2, NXCD = 8, WGM = 8;
typedef f32x4 Acc[2][2][4][2];
DI int lds_byte(int r, int c) { int st = (r >> 4) * 2 + (c >> 5), rr = r & 15, cc = c & 31, ob = rr * 64 + cc * 2; return st * 1024 + (ob ^ (((ob >> 9) & 1) << 5)); }
DI void stage_rc(int b, int& R, int& C) { int st = b / 1024, sb = b % 1024, swz = sb ^ (((sb >> 9) & 1) << 5); R = (st >> 1) * 16 + swz / 64; C = (st & 1) * 32 + (swz % 64) / 2; }

DI int perm32(int rho) { const int n = rho >> 4, i = rho & 15; return 8 * (i >> 2) + 4 * n + (i & 3); }
DI bool tile_coords(int L, int nM, int nN, int& pm, int& pn) {
  const int nwg = nM * nN; if (L >= nwg) return false;
  int wgid = L; { const int q = nwg / NXCD, r = nwg % NXCD, xcd = wgid % NXCD, off = wgid / NXCD; wgid = (xcd < r ? xcd * (q + 1) : r * (q + 1) + (xcd - r) * q) + off; }
  const int nig = WGM * nN, gid = wgid / nig, fm = gid * WGM, gsz = (nM - fm) < WGM ? (nM - fm) : WGM;
  pm = fm + ((wgid % nig) % gsz); pn = (wgid % nig) / gsz; return true;
}

DI void zero_acc(Acc& acc) {
#pragma unroll
  for (int a = 0; a < 2; ++a)
#pragma unroll
    for (int b = 0; b < 2; ++b)
#pragma unroll
      for (int m = 0; m < 4; ++m)
#pragma unroll
        for (int n = 0; n < 2; ++n) acc[a][b][m][n] = (f32x4){0.f, 0.f, 0.f, 0.f};
}

template <class F> DI void epi_loop(Acc& acc, int pm, int pn, int wr, int wc, int fr, int fq, F&& f) {
#pragma unroll
  for (int ai = 0; ai < 2; ++ai)
#pragma unroll
    for (int m = 0; m < 4; ++m) {
      const int row = pm * BM + ai * HALF + wr * 64 + m * 16 + fr;
#pragma unroll
      for (int bj = 0; bj < 2; ++bj) { const int col8 = pn * BM + wc * 64 + bj * 32 + fq * 8; f(row, col8, acc[ai][bj][m][0], acc[ai][bj][m][1]); }
    }
}
DI u32x4 pk8(const f32x4& a, const f32x4& b) { u32x4 w; w.x = pk2(a[0], a[1]); w.y = pk2(a[2], a[3]); w.z = pk2(b[0], b[1]); w.w = pk2(b[2], b[3]); return w; }
template <bool NT = false> DI void st_rows16(void* base, unsigned pitch_b, unsigned row0, unsigned col0, int fr, int fq, const u32x4& w0, const u32x4& w1) {
  u32x4 x;
#pragma unroll
  for (int e = 0; e < 4; ++e) x[e] = (unsigned)__builtin_amdgcn_update_dpp(0, (int)w1[e], 0x128  , 0xf, 0xf, false);
  const bool hi = fr >= 8;
  u32x4 pa, pb;
#pragma unroll
  for (int e = 0; e < 4; ++e) { pa[e] = hi ? x[e] : w0[e]; pb[e] = hi ? w0[e] : x[e]; }
  const unsigned ra = row0 + (unsigned)(fr & 7), ca = col0 + 8u * fq + (hi ? 32u : 0u), cb = col0 + 8u * fq + (hi ? 0u : 32u);
  if (NT) { __builtin_nontemporal_store(pa, (u32x4*)((char*)base + (ra * pitch_b + ca * 2u))); __builtin_nontemporal_store(pb, (u32x4*)((char*)base + ((ra + 8u) * pitch_b + cb * 2u))); }
  else { gst<u32x4>(base, ra * pitch_b + ca * 2u, pa); gst<u32x4>(base, (ra + 8u) * pitch_b + cb * 2u, pb); }
}
DI void unpk8(const u32x4& w, f32x4& a, f32x4& b) { a[0] = bf_lo(w.x); a[1] = bf_hi(w.x); a[2] = bf_lo(w.y); a[3] = bf_hi(w.y); b[0] = bf_lo(w.z); b[1] = bf_hi(w.z); b[2] = bf_lo(w.w); b[3] = bf_hi(w.w); }

template <bool SP2, bool ALIGN_EPI, bool DUAL, class Epi> DI void gemm_phase2(const bf16_t* A, const bf16_t* Bt, const bf16_t* A2, const bf16_t* Bt2, int M, int N, int K, const Epi& E, lds_t* lds) {
  const int nM = M / BM, nN = N / BM, G = gridDim.x, cb = blockIdx.x;
  const int tid = tidx(), wid = __builtin_amdgcn_readfirstlane(tid >> 6), lane = tid & 63, wr = wid >> 2, wc = wid & 3, fr = lane & 15, fq = lane >> 4;
  const int nt = K / BK;
  unsigned voffA[2], voffB[2];
#pragma unroll
  for (int i = 0; i < 2; ++i) { int R, C; stage_rc(tid * 16 + i * 8192, R, C); const int Rb = (R >> 5) * 64 + perm32(R & 31);
    voffA[i] = (unsigned)(R * K + C) * 2u; voffB[i] = (unsigned)(Rb * K + C) * 2u; }
  const size_t kstep = (size_t)(BK * 2), hstep = (size_t)HALF * K * 2, tstep = 2 * hstep, bstep = (size_t)32 * K * 2;
  const unsigned ldsw = (unsigned)wid * 1024u;
  const int aoff = lds_byte(wr * 64 + fr, fq * 8), boff = lds_byte(wc * 32 + fr, fq * 8);
#define SA(b, h) (((b) * 2 + (h)) * HTB)
#define SB(b, h) ((4 + (b) * 2 + (h)) * HTB)
#define STAGE_(bufoff, gbase, voff) do { _Pragma("unroll") for (int _i = 0; _i < 2; ++_i) \
    __builtin_amdgcn_global_load_lds((const __attribute__((address_space(1))) unsigned*)((const char*)(gbase) + voff[_i]), LDSP(unsigned, lds + (bufoff) + ldsw + _i * 8192), 16, 0, 0); } while (0)
#define STAGE(bufoff, gbase) STAGE_(bufoff, gbase, voffA)
#define STAGEB(bufoff, gbase) STAGE_(bufoff, gbase, voffB)
#define LDA(dst, b, h) do { _Pragma("unroll") for (int m = 0; m < 4; ++m) _Pragma("unroll") for (int k = 0; k < 2; ++k) dst[m][k] = *LDSP(const bf16x8, lds + SA(b, h) + aoff + m * 2048 + k * 1024); } while (0)
#define LDB(dst, b, h) do { _Pragma("unroll") for (int n = 0; n < 2; ++n) _Pragma("unroll") for (int k = 0; k < 2; ++k) dst[n][k] = *LDSP(const bf16x8, lds + SB(b, h) + boff + n * 2048 + k * 1024); } while (0)
#define MMA(ai, bj, AT, BT) do { __builtin_amdgcn_s_setprio(1); \
    _Pragma("unroll") for (int m = 0; m < 4; ++m) _Pragma("unroll") for (int n = 0; n < 2; ++n) _Pragma("unroll") for (int k = 0; k < 2; ++k) \
      acc[ai][bj][m][n] = __builtin_amdgcn_mfma_f32_16x16x32_bf16(BT[n][k], AT[m][k], acc[ai][bj][m][n], 0, 0, 0); \
    __builtin_amdgcn_s_setprio(0); } while (0)
#define WAIT_V(n) asm volatile("s_waitcnt vmcnt(" #n ")" ::: "memory")
#define WAIT_L(n) asm volatile("s_waitcnt lgkmcnt(" #n ")" ::: "memory")
#define BAR __builtin_amdgcn_s_barrier()
#define SCHED __builtin_amdgcn_sched_barrier(0)
  int pm, pn, npm = 0, npn = 0, ui = 0, pass = 0;
  if (!tile_coords(cb, nM, nN, pm, pn)) return;
  Acc acc; zero_acc(acc);
  bf16x8 At[4][2], B0[2][2], B1[2][2];
  const char* cA = (const char*)A + (size_t)pm * tstep; const char* cB = (const char*)Bt + (size_t)pn * tstep;
  if constexpr (SP2) {
    STAGEB(SB(0, 0), cB); STAGEB(SB(0, 1), cB + bstep); STAGE(SA(0, 0), cA); STAGE(SA(0, 1), cA + hstep);
    if (wr == 1) BAR;
    WAIT_V(2); BAR;
    STAGEB(SB(1, 0), cB + kstep); STAGE(SA(1, 0), cA + kstep); STAGEB(SB(1, 1), cB + bstep + kstep);
    WAIT_V(6); BAR;
  } else {
    STAGEB(SB(0, 0), cB); STAGE(SA(0, 0), cA); STAGEB(SB(0, 1), cB + bstep); STAGE(SA(0, 1), cA + hstep);
    if (wr == 1) BAR;
    WAIT_V(4); BAR;
    STAGEB(SB(1, 0), cB + kstep); STAGE(SA(1, 0), cA + kstep); STAGEB(SB(1, 1), cB + bstep + kstep);
    WAIT_V(6); BAR;
  }
  for (;;) {
    bool has_next; int npass = 0;
    if (DUAL && pass == 0) { has_next = true; npm = pm; npn = pn; npass = 1; }
    else has_next = tile_coords((ui + 1) * G + cb, nM, nN, npm, npn);
    const char* nAb = (const char*)((DUAL && npass) ? A2 : A); const char* nBb = (const char*)((DUAL && npass) ? Bt2 : Bt);
    const char* nA = has_next ? nAb + (size_t)npm * tstep : cA; const char* nB = has_next ? nBb + (size_t)npn * tstep : cB;
    for (int t = 0; t < nt; t += 2) {
      const bool last = (t == nt - 2);
      const char* a1 = cA + (size_t)(t + 1) * kstep;
      const char* a2 = last ? nA : cA + (size_t)(t + 2) * kstep; const char* b2 = last ? nB : cB + (size_t)(t + 2) * kstep;
      const char* a3 = a2 + kstep; const char* b3 = b2 + kstep;
      if constexpr (SP2) {
        LDB(B0, 0, 0); LDB(B1, 0, 1); SCHED; LDA(At, 0, 0); STAGE(SA(1, 1), a1 + hstep);
        WAIT_V(8); WAIT_L(0); BAR; MMA(0, 0, At, B0); MMA(0, 1, At, B1); BAR; SCHED;
        LDA(At, 0, 1); STAGEB(SB(0, 0), b2); STAGEB(SB(0, 1), b2 + bstep); STAGE(SA(0, 0), a2);
        WAIT_V(8); WAIT_L(0); BAR; MMA(1, 0, At, B0); MMA(1, 1, At, B1); BAR; SCHED;
        LDB(B0, 1, 0); LDB(B1, 1, 1); SCHED; LDA(At, 1, 0); STAGE(SA(0, 1), a2 + hstep);
        WAIT_V(8); WAIT_L(0); BAR; MMA(0, 0, At, B0); MMA(0, 1, At, B1); BAR; SCHED;
        LDA(At, 1, 1); STAGEB(SB(1, 0), b3); STAGEB(SB(1, 1), b3 + bstep); STAGE(SA(1, 0), a3);
        WAIT_V(8); WAIT_L(0); BAR; MMA(1, 0, At, B0); MMA(1, 1, At, B1); BAR; SCHED;
      } else {
        LDB(B0, 0, 0); SCHED; LDA(At, 0, 0); STAGE(SA(1, 1), a1 + hstep);
        WAIT_L(8); BAR; WAIT_L(0); MMA(0, 0, At, B0); BAR; SCHED;
        LDB(B1, 0, 1); STAGEB(SB(0, 0), b2);
        BAR; WAIT_L(0); MMA(0, 1, At, B1); BAR;
        LDA(At, 0, 1); STAGE(SA(0, 0), a2);
        BAR; WAIT_L(0); MMA(1, 0, At, B0); BAR; SCHED;
        STAGEB(SB(0, 1), b2 + bstep);
        WAIT_V(6); BAR; MMA(1, 1, At, B1); BAR;
        LDB(B0, 1, 0); SCHED; LDA(At, 1, 0); STAGE(SA(0, 1), a2 + hstep);
        WAIT_L(8); BAR; WAIT_L(0); MMA(0, 0, At, B0); BAR; SCHED;
        LDB(B1, 1, 1); STAGEB(SB(1, 0), b3);
        BAR; WAIT_L(0); MMA(0, 1, At, B1); BAR;
        LDA(At, 1, 1); STAGE(SA(1, 0), a3);
        BAR; WAIT_L(0); MMA(1, 0, At, B0); BAR; SCHED;
        STAGEB(SB(1, 1), b3 + bstep);
        WAIT_V(6); BAR; MMA(1, 1, At, B1); BAR;
      }
    }
    if constexpr (ALIGN_EPI) { if (wr == 0) BAR; }
    if constexpr (DUAL) { if (pass == 0) E.mid(acc, pm, pn, wr, wc, fr, fq); else E(acc, pm, pn, wr, wc, fr, fq); }
    else E(acc, pm, pn, wr, wc, fr, fq);
    if (!has_next) break;
    if (!(DUAL && pass == 0)) { zero_acc(acc); ++ui; }
    pm = npm; pn = npn; cA = nA; cB = nB; pass = npass;
    if constexpr (ALIGN_EPI) { if (wr == 1) BAR; }
  }
  WAIT_V(0);
  if constexpr (!ALIGN_EPI) { if (wr == 0) BAR; }
  BAR;
#undef SA
#undef SB
#undef STAGE
#undef STAGEB
#undef STAGE_
#undef LDA
#undef LDB
#undef MMA
}
template <bool SP2, bool ALIGN_EPI, class Epi> DI void gemm_phase(const bf16_t* A, const bf16_t* Bt, int M, int N, int K, const Epi& E, lds_t* lds) {
  gemm_phase2<SP2, ALIGN_EPI, false>(A, Bt, nullptr, nullptr, M, N, K, E, lds);
}
}

DI void st_bf4(bf16_t* p, f32x4 v) { u32x2 w; w.x = pk2(v[0], v[1]); w.y = pk2(v[2], v[3]); *(u32x2*)p = w; }

struct EpiProj {
  Params p;
  DI void operator()(g8::Acc& acc, int pm, int pn, int wr, int wc, int fr, int fq) const {
    using namespace g8;
    const int seg = pn >> 2;
    const float* rope = (const float*)(p.ws + OFF_ROPE);
    bf16_t* dst; unsigned ld; int cofs;
    if (seg < 5) { dst = slot(p, seg + 1); ld = 1024; cofs = seg * 1024; } else { dst = (bf16_t*)p.out; ld = 2048; cofs = 5 * 1024; }
    const float qs = (seg == 0) ? 0.125f * LOG2E : 1.0f;
    const float sgn = (fq == 0) ? -1.0f : 1.0f; const bool use = fq < 2;
    const unsigned col0 = (unsigned)(pn * BM + wc * 64 - cofs);
#pragma unroll
    for (int ai = 0; ai < 2; ++ai)
#pragma unroll
      for (int m = 0; m < 4; ++m) {
        const int row0 = pm * BM + ai * HALF + wr * 64 + m * 16, row = row0 + fr;
        u32x4 w[2];
#pragma unroll
        for (int bj = 0; bj < 2; ++bj) {
          f32x4 o0 = acc[ai][bj][m][0], o1 = acc[ai][bj][m][1];
          if (seg < 2) {
            if (bj == 0) {
              const f32x4 c0 = gld<f32x4>(rope, (unsigned)row * 64u), c1 = gld<f32x4>(rope, (unsigned)row * 64u + 16u), s0 = gld<f32x4>(rope, (unsigned)row * 64u + 32u) * sgn, s1 = gld<f32x4>(rope, (unsigned)row * 64u + 48u) * sgn;
              f32x4 p0, p1;
#pragma unroll
              for (int e = 0; e < 4; ++e) { p0[e] = __shfl_xor(o0[e], 16); p1[e] = __shfl_xor(o1[e], 16); }
              const f32x4 r0 = o0 * c0 + p0 * s0, r1 = o1 * c1 + p1 * s1;
#pragma unroll
              for (int e = 0; e < 4; ++e) { o0[e] = use ? r0[e] : o0[e]; o1[e] = use ? r1[e] : o1[e]; }
            }
            o0 = o0 * qs; o1 = o1 * qs;
          } else if (seg == 3 || seg == 4) {
#pragma unroll
            for (int e = 0; e < 4; ++e) {
              { const float xx = o0[e], y2 = (-2.0f * 0.7978845608028654f * LOG2E) * (xx + 0.044715f * xx * xx * xx); o0[e] = xx * __builtin_amdgcn_rcpf(1.0f + __builtin_amdgcn_exp2f(y2)); }
              { const float xx = o1[e], y2 = (-2.0f * 0.7978845608028654f * LOG2E) * (xx + 0.044715f * xx * xx * xx); o1[e] = xx * __builtin_amdgcn_rcpf(1.0f + __builtin_amdgcn_exp2f(y2)); }
            }
          } else if (seg >= 5) {
#pragma unroll
            for (int e = 0; e < 4; ++e) { o0[e] = __builtin_amdgcn_rcpf(1.0f + __builtin_amdgcn_exp2f(-LOG2E * o0[e])); o1[e] = __builtin_amdgcn_rcpf(1.0f + __builtin_amdgcn_exp2f(-LOG2E * o1[e])); }
          }
          w[bj] = pk8(o0, o1);
        }
        st_rows16<true>(dst, ld * 2u, (unsigned)row0, col0, fr, fq, w[0], w[1]);
      }
  }
};

struct EpiPlainBf16 {
  bf16_t* dst; int ld;
  DI void operator()(g8::Acc& acc, int pm, int pn, int wr, int wc, int fr, int fq) const {
    using namespace g8;
#pragma unroll
    for (int ai = 0; ai < 2; ++ai)
#pragma unroll
      for (int m = 0; m < 4; ++m)
        st_rows16(dst, (unsigned)ld * 2u, (unsigned)(pm * BM + ai * HALF + wr * 64 + m * 16), (unsigned)(pn * BM + wc * 64), fr, fq, pk8(acc[ai][0][m][0], acc[ai][0][m][1]), pk8(acc[ai][1][m][0], acc[ai][1][m][1]));
  }
};

struct EpiResid {
  const float* resf; const bf16_t* resb; float* outf; bf16_t* outb; float* ssq;
  DI void operator()(g8::Acc& acc, int pm, int pn, int wr, int wc, int fr, int fq) const {
    using namespace g8;
#pragma unroll
    for (int ai = 0; ai < 2; ++ai)
#pragma unroll
      for (int m = 0; m < 4; ++m) {
        const int row = pm * BM + ai * HALF + wr * 64 + m * 16 + fr; float s = 0.f; u32x4 wv[2];
#pragma unroll
        for (int bj = 0; bj < 2; ++bj) {
          const int col8 = pn * BM + wc * 64 + bj * 32 + fq * 8; const unsigned eo = (unsigned)row * DM + (unsigned)col8;
          f32x4 r0, r1;
          if (resf) { r0 = gld_nt<f32x4>(resf, eo * 4u); r1 = gld_nt<f32x4>(resf, eo * 4u + 16u); }
          else unpk8(gld_nt<u32x4>(resb, eo * 2u), r0, r1);
          const f32x4 o0 = r0 + acc[ai][bj][m][0], o1 = r1 + acc[ai][bj][m][1];
          if (outf) { gst<f32x4>(outf, eo * 4u, o0); gst<f32x4>(outf, eo * 4u + 16u, o1); }
          wv[bj] = pk8(o0, o1);
          s += o0[0] * o0[0] + o0[1] * o0[1] + o0[2] * o0[2] + o0[3] * o0[3] + o1[0] * o1[0] + o1[1] * o1[1] + o1[2] * o1[2] + o1[3] * o1[3];
        }
        if (outb) st_rows16(outb, DM * 2u, (unsigned)(row - fr), (unsigned)(pn * BM + wc * 64), fr, fq, wv[0], wv[1]);
        s += __shfl_xor(s, 16); s += __shfl_xor(s, 32);
        if (fq == 0) atomicAdd(ssq + row, s);
        __builtin_amdgcn_sched_barrier(0);
      }
  }
};

struct EpiResidFinal {
  const bf16_t* resb; float* outf; float* ssq; unsigned* cnt; const float* g;
  DI void operator()(g8::Acc& acc, int pm, int pn, int wr, int wc, int fr, int fq) const {
    using namespace g8;
#pragma unroll
    for (int ai = 0; ai < 2; ++ai)
#pragma unroll
      for (int m = 0; m < 4; ++m) {
        const int row = pm * BM + ai * HALF + wr * 64 + m * 16 + fr; float sq = 0.f;
#pragma unroll
        for (int bj = 0; bj < 2; ++bj) {
          const int col8 = pn * BM + wc * 64 + bj * 32 + fq * 8; const unsigned eo = (unsigned)row * DM + (unsigned)col8;
          f32x4 r0, r1; unpk8(gld_nt<u32x4>(resb, eo * 2u), r0, r1);
          acc[ai][bj][m][0] = acc[ai][bj][m][0] + r0; acc[ai][bj][m][1] = acc[ai][bj][m][1] + r1;
          const f32x4 o0 = acc[ai][bj][m][0], o1 = acc[ai][bj][m][1];
          sq += o0[0] * o0[0] + o0[1] * o0[1] + o0[2] * o0[2] + o0[3] * o0[3] + o1[0] * o1[0] + o1[1] * o1[1] + o1[2] * o1[2] + o1[3] * o1[3];
        }
        sq += __shfl_xor(sq, 16); sq += __shfl_xor(sq, 32);
        if (fq == 0) atomicAdd(ssq + row, sq);
      }
    asm volatile("s_waitcnt vmcnt(0)" ::: "memory");
    __syncthreads();
    if (threadIdx.x == 0) {
      __hip_atomic_fetch_add(cnt + pm, 1u, __ATOMIC_RELAXED, __HIP_MEMORY_SCOPE_AGENT);
      unsigned sp = 0;
      while (__hip_atomic_load(cnt + pm, __ATOMIC_RELAXED, __HIP_MEMORY_SCOPE_AGENT) < 4u) { __builtin_amdgcn_s_sleep(1); if (++sp > (1u << 22)) break; }
    }
    __syncthreads();
#pragma unroll
    for (int ai = 0; ai < 2; ++ai)
#pragma unroll
      for (int m = 0; m < 4; ++m) {
        const int row = pm * BM + ai * HALF + wr * 64 + m * 16 + fr;
        const float rs = rsqrtf(__hip_atomic_load(ssq + row, __ATOMIC_RELAXED, __HIP_MEMORY_SCOPE_AGENT) * (1.0f / DM) + RMS_EPS);
#pragma unroll
        for (int bj = 0; bj < 2; ++bj) {
          const int col8 = pn * BM + wc * 64 + bj * 32 + fq * 8; const unsigned eo = (unsigned)row * DM + (unsigned)col8;
          gst<f32x4>(outf, eo * 4u, acc[ai][bj][m][0] * rs * gld<f32x4>(g, (unsigned)col8 * 4u));
          gst<f32x4>(outf, eo * 4u + 16u, acc[ai][bj][m][1] * rs * gld<f32x4>(g, (unsigned)col8 * 4u + 16u));
        }
      }
  }
};

struct EpiRowScale {
  bf16_t* dst; int ld; const float* ssq; float sc; int act;
  DI void operator()(g8::Acc& acc, int pm, int pn, int wr, int wc, int fr, int fq) const {
    using namespace g8;
#pragma unroll
    for (int ai = 0; ai < 2; ++ai)
#pragma unroll
      for (int m = 0; m < 4; ++m) {
        const int row = pm * BM + ai * HALF + wr * 64 + m * 16 + fr; const float rs = rsqrtf(ssq[row] * (1.0f / DM) + RMS_EPS) * sc;
        u32x4 wv[2];
#pragma unroll
        for (int bj = 0; bj < 2; ++bj) {
          f32x4 o0 = acc[ai][bj][m][0] * rs, o1 = acc[ai][bj][m][1] * rs;
          if (act) {
#pragma unroll
            for (int e = 0; e < 4; ++e) { const float a = fmaxf(o0[e], 0.f), b = fmaxf(o1[e], 0.f); o0[e] = a * a; o1[e] = b * b; } }
          wv[bj] = pk8(o0, o1);
        }
        st_rows16(dst, (unsigned)ld * 2u, (unsigned)(row - fr), (unsigned)(pn * BM + wc * 64), fr, fq, wv[0], wv[1]);
        __builtin_amdgcn_sched_barrier(0);
      }
  }
};

struct EpiGateDual {
  bf16_t* dst; const bf16_t* gates;
  DI void mid(g8::Acc& acc, int pm, int pn, int wr, int wc, int fr, int fq) const {
    using namespace g8;
#pragma unroll
    for (int ai = 0; ai < 2; ++ai)
#pragma unroll
      for (int m = 0; m < 4; ++m) {
        const int row = pm * BM + ai * HALF + wr * 64 + m * 16 + fr;
#pragma unroll
        for (int bj = 0; bj < 2; ++bj) {
          const int col8 = pn * BM + wc * 64 + bj * 32 + fq * 8; const unsigned go = ((unsigned)row * 2048u + (unsigned)col8) * 2u;
          f32x4 a0, a1, s0, s1; unpk8(gld_nt<u32x4>(gates, go), a0, a1); unpk8(gld<u32x4>(gates, go + 2048u), s0, s1);
#pragma unroll
          for (int e = 0; e < 4; ++e) { acc[ai][bj][m][0][e] *= a0[e] * __builtin_amdgcn_rcpf(fmaxf(s0[e], 1e-30f)); acc[ai][bj][m][1][e] *= a1[e] * __builtin_amdgcn_rcpf(fmaxf(s1[e], 1e-30f)); }
        }
        __builtin_amdgcn_sched_barrier(0);
      }
  }
  DI void operator()(g8::Acc& acc, int pm, int pn, int wr, int wc, int fr, int fq) const {
    using namespace g8;
#pragma unroll
    for (int ai = 0; ai < 2; ++ai)
#pragma unroll
      for (int m = 0; m < 4; ++m) {
        const int row0 = pm * BM + ai * HALF + wr * 64 + m * 16, row = row0 + fr; u32x4 wv[2];
#pragma unroll
        for (int bj = 0; bj < 2; ++bj) {
          const int col8 = pn * BM + wc * 64 + bj * 32 + fq * 8; const unsigned go = ((unsigned)row * 2048u + (unsigned)(1024 + col8)) * 2u;
          f32x4 s0, s1; unpk8(gld_nt<u32x4>(gates, go), s0, s1);
#pragma unroll
          for (int e = 0; e < 4; ++e) { s0[e] = fmaxf(s0[e], 1e-30f); s1[e] = fmaxf(s1[e], 1e-30f); }
          wv[bj] = pk8(acc[ai][bj][m][0] * s0, acc[ai][bj][m][1] * s1);
        }
        st_rows16(dst, DM * 2u, (unsigned)row0, (unsigned)(pn * BM + wc * 64), fr, fq, wv[0], wv[1]);
      }
  }
};
DI void merged_phase(const Params& p, lds_t* shm) {
  g8::gemm_phase2<GSP2, GALIGN, true>(slot(p, 0), wt(p, W_BA), slot(p, 4), wt(p, W_BS), T_TOK, DM, DM, EpiGateDual{slot(p, 1), (const bf16_t*)p.out}, shm);
}

DI void wt_transpose(const float* W, bf16_t* Wt, const float* gain, int K, int N, lds_t* shm) {
  const int tk = K / 64, tn = N / 64, tid = tidx();
  __attribute__((address_space(3))) float* tile = LDSP(float, shm);
  for (int t = blockIdx.x; t < tk * tn; t += gridDim.x) {
    const int k0 = (t / tn) * 64, n0 = (t % tn) * 64;
    const int r = tid >> 4, c4 = (tid & 15) * 4;
#pragma unroll
    for (int i = 0; i < 2; ++i) {
      const int kk = r + 32 * i; f32x4 v = __builtin_nontemporal_load((const f32x4*)(W + (size_t)(k0 + kk) * N + n0 + c4));
      if (gain) v = v * gain[k0 + kk];
      tile[kk * 65 + c4 + 0] = v[0]; tile[kk * 65 + c4 + 1] = v[1]; tile[kk * 65 + c4 + 2] = v[2]; tile[kk * 65 + c4 + 3] = v[3];
    }
    __syncthreads();
    const int nn = tid >> 3, k8 = (tid & 7) * 8;
    u32x4 w;
    w.x = pk2(tile[(k8 + 0) * 65 + nn], tile[(k8 + 1) * 65 + nn]); w.y = pk2(tile[(k8 + 2) * 65 + nn], tile[(k8 + 3) * 65 + nn]);
    w.z = pk2(tile[(k8 + 4) * 65 + nn], tile[(k8 + 5) * 65 + nn]); w.w = pk2(tile[(k8 + 6) * 65 + nn], tile[(k8 + 7) * 65 + nn]);
    *(u32x4*)(Wt + (size_t)(n0 + nn) * K + k0 + k8) = w;
    __syncthreads();
  }
}

DI void rms_rows(const float* X, const float* g, bf16_t* out, int nrows) {
  const int wid = tidx() >> 6, lane = tidx() & 63; const int stride = gridDim.x * 8;
  for (int r = blockIdx.x * 8 + wid; r < nrows; r += 2 * stride) {
    const int r2 = r + stride; const bool has2 = r2 < nrows;
    const f32x4* xa = (const f32x4*)(X + (size_t)r * DM); const f32x4* xb = (const f32x4*)(X + (size_t)(has2 ? r2 : r) * DM);
    f32x4 va[4], vb[4]; float sa = 0.f, sb = 0.f;
#pragma unroll
    for (int i = 0; i < 4; ++i) { va[i] = __builtin_nontemporal_load(xa + lane + 64 * i); vb[i] = __builtin_nontemporal_load(xb + lane + 64 * i); }
#pragma unroll
    for (int i = 0; i < 4; ++i) { sa += va[i][0] * va[i][0] + va[i][1] * va[i][1] + va[i][2] * va[i][2] + va[i][3] * va[i][3]; sb += vb[i][0] * vb[i][0] + vb[i][1] * vb[i][1] + vb[i][2] * vb[i][2] + vb[i][3] * vb[i][3]; }
    sa = wave_sum(sa); sb = wave_sum(sb);
    const float ra = rsqrtf(sa * (1.0f / DM) + RMS_EPS), rb = rsqrtf(sb * (1.0f / DM) + RMS_EPS);
#pragma unroll
    for (int i = 0; i < 4; ++i) { const f32x4 gg = ((const f32x4*)g)[lane + 64 * i];
      st_bf4(out + (size_t)r * DM + (lane + 64 * i) * 4, va[i] * ra * gg);
      if (has2) st_bf4(out + (size_t)r2 * DM + (lane + 64 * i) * 4, vb[i] * rb * gg); }
  }
}

DI void prep_phase(const Params& p, lds_t* shm) {
  const int gt = blockIdx.x * NTHR + tidx(), gn = gridDim.x * NTHR;
  float* rope = (float*)(p.ws + OFF_ROPE);
  for (int i = gt; i < T_TOK * 8; i += gn) {
    const int t = i >> 3, f = i & 7; const float inv = (float)exp2(-(double)f * 0.125 * 18.931568569324174  );
    const float ang = (float)p.pos[t] * inv; float s, c; sincosf(ang, &s, &c); rope[t * 16 + f] = c; rope[t * 16 + 8 + f] = s;
  }
  float* ssq = (float*)(p.ws + OFF_SSQ);
  for (int i = gt; i < 3 * T_TOK; i += gn) ssq[i] = 0.f;
  bf16_t* wm = (bf16_t*)(p.ws + OFF_WM);
  for (int i = gt; i < 8 * 128 * 128 / 2; i += gn) {
    const int e = i * 2, ii = (e >> 7) & 127, j = e & 127; const f32x2 w = *(const f32x2*)(p.sg_w + e);
    const bool ok = (j >> 6) <= (ii >> 6); ((unsigned*)wm)[i] = ok ? pk2(w[0], w[1]) : 0u;
  }
  rms_rows(p.x, p.g_mix, slot(p, 0), T_TOK);
  rms_rows(p.mem, p.g_mem, (bf16_t*)(p.ws + OFF_MEMN), 1024);
  wt_transpose(p.w_in, wt(p, W_IN), nullptr, 1024, 7168, shm);
  wt_transpose(p.w_ba, wt(p, W_BA), nullptr, 1024, 1024, shm);
  wt_transpose(p.w_bs, wt(p, W_BS), nullptr, 1024, 1024, shm);
  wt_transpose(p.w_out, wt(p, W_OUT), nullptr, 1024, 1024, shm);
  wt_transpose(p.w_xq, wt(p, W_XQ), p.g_xa, 1024, 1024, shm);
  wt_transpose(p.w_xkv, wt(p, W_XKV), nullptr, 1024, 2048, shm);
  wt_transpose(p.w_xo, wt(p, W_XO), nullptr, 1024, 1024, shm);
  wt_transpose(p.w_ff1, wt(p, W_FF1), p.g_ffn, 1024, 4096, shm);
  wt_transpose(p.w_ff2, wt(p, W_FF2), nullptr, 4096, 1024, shm);
}

DI unsigned off_a(unsigned row, unsigned ch) { return 2048u * (row >> 3) + 512u * (ch >> 2) + 64u * (row & 7) + 16u * ((ch & 3) ^ ((row >> 2) & 3)); }
DI void inv_off_a(unsigned L, unsigned& row, unsigned& ch) {
  const unsigned o = L * 16u, b8 = o >> 11, rem = o & 2047u, chq = rem >> 9, rem2 = rem & 511u, r7 = rem2 >> 6, cx = (rem2 & 63u) >> 4;
  row = b8 * 8 + r7; ch = chq * 4 + (cx ^ ((row >> 2) & 3));
}
DI bf16x8 tr_pair(lds_t* a0, lds_t* a1) {
  const s16x4 lo = __builtin_amdgcn_ds_read_tr16_b64_v4i16(LDSP(s16x4, a0)), hi = __builtin_amdgcn_ds_read_tr16_b64_v4i16(LDSP(s16x4, a1));
  return __builtin_shufflevector(lo, hi, 0, 1, 2, 3, 4, 5, 6, 7);
}

DI void glds16(const void* base, unsigned off, lds_t* dst) {
  __builtin_amdgcn_global_load_lds((const __attribute__((address_space(1))) unsigned*)((const char*)base + off), LDSP(unsigned, dst), 16, 0, 0);
}

DI void dattn_unit2(const bf16_t* __restrict__ Qg, const bf16_t* __restrict__ Kg, const bf16_t* __restrict__ Vg, bf16_t* __restrict__ Og,
                    int ntiles, int wave_tiles, float lam, const float* __restrict__ gsub, lds_t* shm) {
  constexpr int NC = 4, LD = DM;
  constexpr unsigned VRING = 3 * 16384;
  const int tid = tidx(), lane = tid & 63, h = lane >> 5, l31 = lane & 31, wid = __builtin_amdgcn_readfirstlane(tid >> 6), grp = wid >> 2;
  unsigned soff[2];
#pragma unroll
  for (int i = 0; i < 2; ++i) { unsigned r, c; inv_off_a(tid + 512 * i, r, c); soff[i] = (r * (unsigned)LD + c * 8u) * 2u; }
  constexpr unsigned tstep = 64u * LD * 2u;
  const int last_tile = ntiles - 1;
  auto issueK = [&](int kt, int slot) __attribute__((always_inline)) {
    const int t = kt < last_tile ? kt : last_tile; lds_t* base = shm + slot * 16384 + wid * 1024; const char* kb = (const char*)Kg + (size_t)t * tstep;
    glds16(kb, soff[0], base); glds16(kb, soff[1], base + 8192);
  };
  auto issueV = [&](int kt, int slot) __attribute__((always_inline)) {
    const int t = kt < last_tile ? kt : last_tile; lds_t* base = shm + VRING + slot * 16384 + wid * 1024; const char* vb = (const char*)Vg + (size_t)t * tstep;
    glds16(vb, soff[0], base); glds16(vb, soff[1], base + 8192);
  };
#define WAIT_V(n) asm volatile("s_waitcnt vmcnt(" #n ")" ::: "memory")
#define BAR do { __builtin_amdgcn_sched_barrier(0); __builtin_amdgcn_s_barrier(); asm volatile("" ::: "memory"); __builtin_amdgcn_sched_barrier(0); } while (0)
  __syncthreads();
  lds_t* Qst = shm + 6 * 16384 + wid * 8192;
#pragma unroll
  for (int i = 0; i < 8; ++i) { unsigned r, c; inv_off_a(lane + 64 * i, r, c); glds16(Qg, (r * (unsigned)LD + c * 8u) * 2u, Qst + i * 1024); }
  issueK(0, 0); issueV(0, 0); issueK(1, 1); issueV(1, 1);
  f32x16 O[2][NC];
#pragma unroll
  for (int m = 0; m < 2; ++m)
#pragma unroll
    for (int c = 0; c < NC; ++c)
#pragma unroll
      for (int i = 0; i < 16; ++i) O[m][c][i] = 0.f;
  float mrun[2] = {-INFINITY, -INFINITY}, lrun[2] = {0.f, 0.f};
  const unsigned q4 = (lane & 15) >> 2, pp = lane & 3, blk = (lane >> 4) & 1;
  const unsigned xk = (l31 >> 2) & 3, kbase = 2048u * (l31 >> 3) + 64u * (l31 & 7);
  const unsigned ka0 = kbase + 16u * ((unsigned)h ^ xk), ka2 = kbase + 16u * ((2u + h) ^ xk);
  const unsigned vrow = 64u * (4u * h + q4), cl = 2u * blk + (pp >> 1);
  const unsigned va0 = VRING + vrow + 16u * (cl ^ (unsigned)h) + 8u * (pp & 1), va1 = VRING + vrow + 16u * (cl ^ ((unsigned)h ^ 2u)) + 8u * (pp & 1);
  WAIT_V(6); BAR;
  if (grp == 1) { WAIT_V(4); BAR; }
  int slot = 0;
  for (int kt = 0; kt < ntiles; ++kt) {
    const int slot2 = slot >= 1 ? slot - 1 : 2;
    issueK(kt + 2, slot2);
    const float msk = (kt < wave_tiles) ? 0.f : -INFINITY;
    const unsigned so = slot * 16384;
    lds_t* K0 = shm + (so + ka0); lds_t* K2 = shm + (so + ka2);
    bf16x8 P[2][2][2]; float alpha[2]; bool resc[2];
#pragma unroll
    for (int m = 0; m < 2; ++m) {
      f32x16 s[2];
#pragma unroll
      for (int kb = 0; kb < 2; ++kb)
#pragma unroll
        for (int i = 0; i < 16; ++i) s[kb][i] = 0.f;
#pragma unroll
      for (int ss = 0; ss < 4; ++ss) {
        const bf16x8 qv = *LDSP(const bf16x8, Qst + ((ss & 1) ? ka2 : ka0) + 512 * (ss >> 1) + 1024 * m);
#pragma unroll
        for (int kb = 0; kb < 2; ++kb) {
          const bf16x8 kf = *LDSP(const bf16x8, ((ss & 1) ? K2 : K0) + kb * 8192 + 512 * (ss >> 1) + 1024 * m);
          s[kb] = MFMA32(kf, qv, s[kb]);
        }
      }
      float mx = s[0][0];
#pragma unroll
      for (int i = 1; i < 16; ++i) mx = fmaxf(mx, s[0][i]);
#pragma unroll
      for (int i = 0; i < 16; ++i) mx = fmaxf(mx, s[1][i]);
      { const auto sw = __builtin_amdgcn_permlane32_swap(__float_as_uint(mx), __float_as_uint(mx), false, false); mx = fmaxf(__uint_as_float(sw[0]), __uint_as_float(sw[1])) + msk; }
      resc[m] = __builtin_amdgcn_ballot_w64(mx > mrun[m] + 8.0f) != 0;
      alpha[m] = 1.0f;
      if (resc[m]) { const float mnew = fmaxf(mrun[m], mx); alpha[m] = __builtin_amdgcn_exp2f(mrun[m] - mnew); mrun[m] = mnew; lrun[m] *= alpha[m]; }
      const float msub = mrun[m] - msk;
      float rs = 0.f;
#pragma unroll
      for (int kb = 0; kb < 2; ++kb)
#pragma unroll
        for (int s2 = 0; s2 < 2; ++s2) {
          float e[8];
#pragma unroll
          for (int j = 0; j < 8; ++j) { e[j] = __builtin_amdgcn_exp2f(s[kb][8 * s2 + j] - msub); rs += e[j]; }
          u32x4 w; w.x = pk2(e[0], e[1]); w.y = pk2(e[2], e[3]); w.z = pk2(e[4], e[5]); w.w = pk2(e[6], e[7]);
          P[m][kb][s2] = __builtin_bit_cast(bf16x8, w);
          __builtin_amdgcn_sched_barrier(0);
        }
      lrun[m] += rs;
      __builtin_amdgcn_sched_barrier(0);
    }
    __builtin_amdgcn_sched_barrier(0);
    WAIT_V(4); BAR;
    issueV(kt + 2, slot2);
    lds_t* V0 = shm + (so + va0); lds_t* V1 = shm + (so + va1);
#pragma unroll
    for (int m = 0; m < 2; ++m)
      if (resc[m]) {
#pragma unroll
        for (int c = 0; c < NC; ++c) O[m][c] = O[m][c] * alpha[m];
      }
#pragma unroll
    for (int ks = 0; ks < 4; ++ks) {
      bf16x8 vf[NC];
#pragma unroll
      for (int c = 0; c < NC; ++c) { const int vo = 512 * c + 4096 * ks; vf[c] = tr_pair(V0 + vo, V1 + vo + 2048); }
#pragma unroll
      for (int c = 0; c < NC; ++c) { O[0][c] = MFMA32(vf[c], P[0][ks >> 1][ks & 1], O[0][c]); O[1][c] = MFMA32(vf[c], P[1][ks >> 1][ks & 1], O[1][c]); }
    }
    __builtin_amdgcn_sched_barrier(0);
    WAIT_V(4); BAR;
    slot = slot == 2 ? 0 : slot + 1;
  }
  if (grp == 0) BAR;
#undef WAIT_V
#undef BAR
  const float l0 = lrun[0] + __shfl_xor(lrun[0], 32), l1 = lrun[1] + __shfl_xor(lrun[1], 32);
  const float i0 = 1.0f / l0, i1 = lam / l1;
  float ssq = 0.f;
#pragma unroll
  for (int c = 0; c < NC; ++c)
#pragma unroll
    for (int i = 0; i < 16; ++i) { const float a = O[0][c][i] * i0 - O[1][c][i] * i1; O[0][c][i] = a; ssq += a * a; }
  ssq += __shfl_xor(ssq, 32);
  const float inv = rsqrtf(ssq * (1.0f / 128.0f) + RMS_EPS) * 0.8f;
  const int lane_f = tidx() & 63, h_f = lane_f >> 5;
  const unsigned ooff = ((unsigned)(lane_f & 31) * (unsigned)LD + 4u * h_f) * 2u;
#pragma unroll
  for (int c = 0; c < NC; ++c)
#pragma unroll
    for (int g4 = 0; g4 < 4; ++g4) {
      const int dv0 = 32 * c + 8 * g4; f32x4 o;
#pragma unroll
      for (int e = 0; e < 4; ++e) o[e] = O[0][c][4 * g4 + e] * inv;
      o = o * gld<f32x4>(gsub + dv0, 16u * h_f);
      u32x2 w; w.x = pk2(o[0], o[1]); w.y = pk2(o[2], o[3]);
      gst<u32x2>(Og + dv0, ooff, w);
    }
}

DI void diff_attn_phase(const Params& p, lds_t* shm) {
  const int wid = __builtin_amdgcn_readfirstlane(tidx() >> 6), lane = tidx() & 63;
  const float d1 = wave_sum(p.lq1[lane] * p.lk1[lane]), d2 = wave_sum(p.lq2[lane] * p.lk2[lane]);
  const float lam = __uint_as_float(__builtin_amdgcn_readfirstlane(__float_as_uint(expf(d1) - expf(d2) + 0.2f)));
  const bf16_t *Q = slot(p, 1), *K = slot(p, 2), *V = slot(p, 3); bf16_t* A = slot(p, 0);
  const int nit = (gridDim.x == 256) ? 2 : (512 + gridDim.x - 1) / gridDim.x;
  for (int it = 0; it < nit; ++it) {
    int pi;
    if (gridDim.x == 256) { const int x = blockIdx.x & 7, j = blockIdx.x >> 3, t = j + 32 * it; pi = (4 * x + (t >> 4)) * 16 + (t & 15); }
    else { pi = blockIdx.x + it * gridDim.x; if (pi >= 512) break; }
    const int bh = pi >> 4, pp = pi & 15, b = bh >> 3, hd = bh & 7;
    for (int e = 0; e < 2; ++e) {
      const int qb = e ? pp : 31 - pp; const size_t r0 = (size_t)b * SEQ + qb * 256 + wid * 32;
      dattn_unit2(Q + r0 * DM + hd * 128, K + (size_t)b * SEQ * DM + hd * 128, V + (size_t)b * SEQ * DM + hd * 128, A + r0 * DM + hd * 128,
                  qb * 4 + 4, qb * 4 + (wid >> 1) + 1, lam, p.g_subln, shm);
    }
  }
}

DI void xattn_unit(const bf16_t* __restrict__ Qg, const bf16_t* __restrict__ Kg, const bf16_t* __restrict__ Vg, bf16_t* __restrict__ Og, lds_t* shm) {
  constexpr int LDQ = DM, LDKV = 2048, NC = 8;
  const int tid = tidx(), lane = tid & 63, h = lane >> 5, l31 = lane & 31, wid = __builtin_amdgcn_readfirstlane(tid >> 6);
  unsigned soff[2];
#pragma unroll
  for (int i = 0; i < 2; ++i) { unsigned r, c; inv_off_a(tid + 512 * i, r, c); soff[i] = (r * (unsigned)LDKV + c * 8u) * 2u; }
  constexpr unsigned tstep = 64u * LDKV * 2u;
  auto issue_tile = [&](const bf16_t* src, int t, unsigned lds_base) __attribute__((always_inline)) {
    const char* sb = (const char*)src + (size_t)t * tstep; lds_t* base = shm + lds_base + wid * 1024;
#pragma unroll
    for (int im = 0; im < 2; ++im) { glds16(sb + im * 256, soff[0], base + im * 16384); glds16(sb + im * 256, soff[1], base + im * 16384 + 8192); }
  };
  __syncthreads();
#pragma unroll
  for (int t = 0; t < 4; ++t) issue_tile(Kg, t, t * 32768);
  issue_tile(Vg, 0, 131072);
  const unsigned q4 = (lane & 15) >> 2, pp = lane & 3, blk = (lane >> 4) & 1;
  const unsigned xk = (l31 >> 2) & 3, kbase = 2048u * (l31 >> 3) + 64u * (l31 & 7);
  const unsigned ka0 = kbase + 16u * ((unsigned)h ^ xk), ka2 = kbase + 16u * ((2u + h) ^ xk);
  const unsigned vrow = 64u * (4u * h + q4), cl = 2u * blk + (pp >> 1);
  const unsigned va0 = vrow + 16u * (cl ^ (unsigned)h) + 8u * (pp & 1), va1 = vrow + 16u * (cl ^ ((unsigned)h ^ 2u)) + 8u * (pp & 1);
  const unsigned qoff = ((unsigned)l31 * (unsigned)LDQ + 8u * h) * 2u;
  f32x16 S[4][2];
#pragma unroll
  for (int t = 0; t < 4; ++t)
#pragma unroll
    for (int kb = 0; kb < 2; ++kb)
#pragma unroll
      for (int i = 0; i < 16; ++i) S[t][kb][i] = 0.f;
  asm volatile("s_waitcnt vmcnt(0)" ::: "memory");
  __syncthreads();
  __builtin_amdgcn_sched_barrier(0);
#pragma unroll
  for (int ss = 0; ss < 16; ++ss) {
    const int cgl = 2 * ss, img = cgl >> 4;
    const bf16x8 qv = gld<bf16x8>(Qg + 16 * ss, qoff);
#pragma unroll
    for (int t = 0; t < 4; ++t)
#pragma unroll
      for (int kb = 0; kb < 2; ++kb) {
        const bf16x8 kf = *LDSP(const bf16x8, shm + t * 32768 + img * 16384 + kb * 8192 + 512 * ((cgl & 15) >> 2) + ((cgl & 2) ? ka2 : ka0));
        S[t][kb] = MFMA32(kf, qv, S[t][kb]);
      }
  }
  float mx = S[0][0][0];
#pragma unroll
  for (int t = 0; t < 4; ++t)
#pragma unroll
    for (int kb = 0; kb < 2; ++kb)
#pragma unroll
      for (int i = 0; i < 16; ++i) mx = fmaxf(mx, S[t][kb][i]);
  { const auto sw = __builtin_amdgcn_permlane32_swap(__float_as_uint(mx), __float_as_uint(mx), false, false); mx = fmaxf(__uint_as_float(sw[0]), __uint_as_float(sw[1])); }
  float rs = 0.f;
  bf16x8 P[4][2][2];
#pragma unroll
  for (int t = 0; t < 4; ++t)
#pragma unroll
    for (int kb = 0; kb < 2; ++kb)
#pragma unroll
      for (int s2 = 0; s2 < 2; ++s2) {
        float e[8];
#pragma unroll
        for (int j = 0; j < 8; ++j) { e[j] = __builtin_amdgcn_exp2f(S[t][kb][8 * s2 + j] - mx); rs += e[j]; }
        u32x4 w; w.x = pk2(e[0], e[1]); w.y = pk2(e[2], e[3]); w.z = pk2(e[4], e[5]); w.w = pk2(e[6], e[7]);
        P[t][kb][s2] = __builtin_bit_cast(bf16x8, w);
      }
  const float l = rs + __shfl_xor(rs, 32);
  __builtin_amdgcn_sched_barrier(0);
  __syncthreads();
  __builtin_amdgcn_sched_barrier(0);
#pragma unroll
  for (int t = 1; t < 4; ++t) issue_tile(Vg, t, t * 32768);
  f32x16 O[NC];
#pragma unroll
  for (int c = 0; c < NC; ++c)
#pragma unroll
    for (int i = 0; i < 16; ++i) O[c][i] = 0.f;
#pragma unroll
  for (int t = 0; t < 4; ++t) {
    if (t == 1) { __builtin_amdgcn_sched_barrier(0); asm volatile("s_waitcnt vmcnt(0)" ::: "memory"); __syncthreads(); __builtin_amdgcn_sched_barrier(0); }
    const unsigned vbase = (t == 0) ? 131072u : (unsigned)t * 32768u;
#pragma unroll
    for (int ks = 0; ks < 4; ++ks)
#pragma unroll
      for (int c = 0; c < NC; ++c) {
        const unsigned vo = vbase + (c >> 2) * 16384 + 512 * (c & 3) + 4096 * ks;
        const bf16x8 vf = tr_pair(shm + vo + va0, shm + vo + 2048 + va1);
        O[c] = MFMA32(vf, P[t][ks >> 1][ks & 1], O[c]);
      }
  }
  const float inv = 1.0f / l;
  const unsigned ooff = ((unsigned)l31 * (unsigned)LDQ + 4u * h) * 2u;
#pragma unroll
  for (int c = 0; c < NC; ++c)
#pragma unroll
    for (int g4 = 0; g4 < 4; ++g4) {
      u32x2 w; w.x = pk2(O[c][4 * g4 + 0] * inv, O[c][4 * g4 + 1] * inv); w.y = pk2(O[c][4 * g4 + 2] * inv, O[c][4 * g4 + 3] * inv);
      gst<u32x2>(Og + 32 * c + 8 * g4, ooff, w);
    }
}

DI void cross_attn_own_tiles(const Params& p, lds_t* shm) {
  const int wid = __builtin_amdgcn_readfirstlane(tidx() >> 6);
  const bf16_t* Q = slot(p, 3); const bf16_t* KV = (const bf16_t*)(p.ws + OFF_KVX); bf16_t* O = slot(p, 0);
  for (int i = 0;; ++i) {
    int pm, pn; if (!g8::tile_coords(i * (int)gridDim.x + (int)blockIdx.x, T_TOK / 256, 4, pm, pn)) break;
    const int b = pm >> 5, hd = pn; const size_t r0 = (size_t)pm * 256 + wid * 32;
    xattn_unit(Q + r0 * DM + hd * 256, KV + (size_t)b * 256 * 2048 + hd * 256, KV + (size_t)b * 256 * 2048 + 1024 + hd * 256, O + r0 * DM + hd * 256, shm);
  }
}

DI void cross_attn_phase(const Params& p, lds_t* shm) {
  const int wid = __builtin_amdgcn_readfirstlane(tidx() >> 6);
  const bf16_t* Q = slot(p, 3); const bf16_t* KV = (const bf16_t*)(p.ws + OFF_KVX); bf16_t* O = slot(p, 0);
  for (int u = blockIdx.x; u < 512; u += gridDim.x) {
    const int bh = u >> 5, qb = u & 31, b = bh >> 2, hd = bh & 3; const size_t r0 = (size_t)b * SEQ + qb * 256 + wid * 32;
    xattn_unit(Q + r0 * DM + hd * 256, KV + (size_t)b * 256 * 2048 + hd * 256, KV + (size_t)b * 256 * 2048 + 1024 + hd * 256, O + r0 * DM + hd * 256, shm);
  }
}

DI void sg_phase(const Params& p, lds_t* shm) {
  const int tid = tidx(), wid = tid >> 6, lane = tid & 63, h = lane >> 5, l31 = lane & 31;
  const bf16_t* Vs = slot(p, 5); bf16_t* U = slot(p, 4); const bf16_t* wm = (const bf16_t*)(p.ws + OFF_WM);
  __attribute__((address_space(3))) float* stats = LDSP(float, shm + 32768);
  const unsigned q4 = (lane & 15) >> 2, pp = lane & 3, blk = (lane >> 4) & 1;
  for (int w = blockIdx.x; w < T_TOK / 128; w += gridDim.x) {
    __syncthreads();
    for (int t4 = 0; t4 < 16; t4 += 4) {
      u32x4 rv[4][2];
#pragma unroll
      for (int q = 0; q < 4; ++q) { const u32x4* rp = (const u32x4*)(Vs + (size_t)(w * 128 + wid * 16 + t4 + q) * DM); rv[q][0] = rp[lane]; rv[q][1] = rp[lane + 64]; }
      float sm[4], sq[4];
#pragma unroll
      for (int q = 0; q < 4; ++q) { float a0 = 0.f, a1 = 0.f;
#pragma unroll
        for (int i = 0; i < 2; ++i)
#pragma unroll
          for (int e = 0; e < 4; ++e) { const float a = bf_lo(rv[q][i][e]), bb = bf_hi(rv[q][i][e]); a0 += a + bb; a1 += a * a + bb * bb; }
        sm[q] = a0; sq[q] = a1; }
#pragma unroll
      for (int q = 0; q < 4; ++q) { sm[q] = wave_sum(sm[q]); sq[q] = wave_sum(sq[q]); }
#pragma unroll
      for (int q = 0; q < 4; ++q) { const int j = wid * 16 + t4 + q; const float mu = sm[q] * (1.0f / DM), var = fmaxf(sq[q] * (1.0f / DM) - mu * mu, 0.f);
        if (lane == 0) { stats[2 * j] = mu; stats[2 * j + 1] = rsqrtf(var + 1e-5f); } }
    }
    u32x4 raw[4];
#pragma unroll
    for (int i = 0; i < 4; ++i) { const int idx = tid + 512 * i, row = idx >> 4, ch = idx & 15; raw[i] = *(const u32x4*)(Vs + (size_t)(w * 128 + row) * DM + ch * 8); }
    for (int g = 0; g < 8; ++g) {
      __syncthreads();
#pragma unroll
      for (int i = 0; i < 4; ++i) {
        const int idx = tid + 512 * i, row = idx >> 4, ch = idx & 15; const int c0 = g * 128 + ch * 8;
        const u32x4 v = raw[i];
        const float mu = stats[2 * row], rs = stats[2 * row + 1];
        const f32x4 g0 = *(const f32x4*)(p.ln_g + c0), g1 = *(const f32x4*)(p.ln_g + c0 + 4), b0 = *(const f32x4*)(p.ln_b + c0), b1 = *(const f32x4*)(p.ln_b + c0 + 4);
        u32x4 o;
        o.x = pk2((bf_lo(v.x) - mu) * rs * g0[0] + b0[0], (bf_hi(v.x) - mu) * rs * g0[1] + b0[1]);
        o.y = pk2((bf_lo(v.y) - mu) * rs * g0[2] + b0[2], (bf_hi(v.y) - mu) * rs * g0[3] + b0[3]);
        o.z = pk2((bf_lo(v.z) - mu) * rs * g1[0] + b1[0], (bf_hi(v.z) - mu) * rs * g1[1] + b1[1]);
        o.w = pk2((bf_lo(v.w) - mu) * rs * g1[2] + b1[2], (bf_hi(v.w) - mu) * rs * g1[3] + b1[3]);
        *LDSP(u32x4, shm + off_a(row, ch)) = o;
      }
      if (g + 1 < 8) {
#pragma unroll
        for (int i = 0; i < 4; ++i) { const int idx = tid + 512 * i, row = idx >> 4, ch = idx & 15; raw[i] = *(const u32x4*)(Vs + (size_t)(w * 128 + row) * DM + (g + 1) * 128 + ch * 8); }
      }
      __syncthreads();
      const int ib = wid & 3, chalf = wid >> 2, nks = (ib < 2) ? 4 : 8;
      f32x16 acc[2];
#pragma unroll
      for (int cc = 0; cc < 2; ++cc)
#pragma unroll
        for (int i = 0; i < 16; ++i) acc[cc][i] = 0.f;
      const bf16_t* wrow = wm + ((size_t)(g * 128 + ib * 32 + l31)) * 128 + 8 * h;
      for (int ks = 0; ks < nks; ++ks) {
        const bf16x8 bfr = *(const bf16x8*)(wrow + 16 * ks);
#pragma unroll
        for (int cc = 0; cc < 2; ++cc) {
          const unsigned chb = 4 * (2 * chalf + cc) + 2 * blk + (pp >> 1);
          const bf16x8 af = tr_pair(shm + off_a(16 * ks + 8 * h + q4, chb) + 8 * (pp & 1), shm + off_a(16 * ks + 8 * h + 4 + q4, chb) + 8 * (pp & 1));
          acc[cc] = MFMA32(af, bfr, acc[cc]);
        }
      }
      const int tok = w * 128 + ib * 32 + l31; const float bias = p.sg_b[g * 128 + ib * 32 + l31];
#pragma unroll
      for (int cc = 0; cc < 2; ++cc)
#pragma unroll
        for (int g4 = 0; g4 < 4; ++g4) {
          bf16_t* up = U + (size_t)tok * DM + g * 128 + 32 * (2 * chalf + cc) + 8 * g4 + 4 * h;
          const u32x2 uu = *(const u32x2*)up; f32x4 o;
          o[0] = bf_lo(uu.x) * (acc[cc][4 * g4 + 0] + bias); o[1] = bf_hi(uu.x) * (acc[cc][4 * g4 + 1] + bias);
          o[2] = bf_lo(uu.y) * (acc[cc][4 * g4 + 2] + bias); o[3] = bf_hi(uu.y) * (acc[cc][4 * g4 + 3] + bias);
          st_bf4(up, o);
        }
    }
  }
}

DI void final_phase(const Params& p) {
  const float* ssq = (const float*)(p.ws + OFF_SSQ) + 2 * T_TOK;
  const int gt = blockIdx.x * NTHR + tidx(), gn = gridDim.x * NTHR;
  for (int i = gt; i < T_TOK * DM / 4; i += gn) {
    const int row = i >> 8, c4 = (i & 255) * 4; const float rs = rsqrtf(ssq[row] * (1.0f / DM) + RMS_EPS);
    f32x4 v = *(f32x4*)(p.out + (size_t)i * 4); v = v * rs * *(const f32x4*)(p.g_final + c4); *(f32x4*)(p.out + (size_t)i * 4) = v;
  }
}


#define XB_TMO      128
#define XB_XCNT(j)  (256  + 64 * (j))
#define XB_XSUB(j)  (1280 + 64 * (j))
#define XB_XGEN(j)  (2304 + 64 * (j))
#define XB_TOP      3328
#define XB_TOPGEN   3392
#define XCD_BAR_WORDS 3456
#define XB_SPIN_CAP (1u << 18)
DI unsigned xb_ld(unsigned* p) { return __hip_atomic_load(p, __ATOMIC_RELAXED, __HIP_MEMORY_SCOPE_AGENT); }
DI unsigned xb_add(unsigned* p, unsigned v) { return __hip_atomic_fetch_add(p, v, __ATOMIC_RELAXED, __HIP_MEMORY_SCOPE_AGENT); }
DI unsigned xb_xcc_id() { return (unsigned)__builtin_amdgcn_s_getreg((3 << 11) | 20) & 0xFu; }
#define XB_SPIN(cond, bar) do { unsigned _sp = 0; while (cond) { __builtin_amdgcn_s_sleep(1); \
    if ((++_sp & 255u) == 0u) { if (xb_ld(&(bar)[XB_TMO])) break; if (_sp > XB_SPIN_CAP) { atomicAdd(&(bar)[XB_TMO], 1u); break; } } } } while (0)
struct XcdBarrier { unsigned* bar; unsigned x, nloc, nx; };
DI unsigned xcd_barrier_post(unsigned* bar) { const unsigned x = xb_xcc_id(); if (threadIdx.x == 0) (void)xb_add(&bar[XB_XCNT(x)], 1u); return x; }
DI void xcd_barrier_complete(unsigned* bar, unsigned x, unsigned& nloc, unsigned& nx) {
  const unsigned G = gridDim.x * gridDim.y * gridDim.z;
  unsigned sum, cnt, mine, sp = 0u;
  for (;;) {
    sum = 0u; cnt = 0u; mine = 0u;
#pragma unroll
    for (unsigned j = 0; j < 16; ++j) { const unsigned c = xb_ld(&bar[XB_XCNT(j)]); sum += c; cnt += (c > 0u) ? 1u : 0u; mine = (j == x) ? c : mine; }
    if (sum == G) break;
    __builtin_amdgcn_s_sleep(1);
    if ((++sp & 255u) == 0u) { if (xb_ld(&bar[XB_TMO])) break; if (sp > XB_SPIN_CAP) { atomicAdd(&bar[XB_TMO], 1u); break; } }
  }
  nloc = mine > 0u ? mine : 1u; nx = cnt > 0u ? cnt : 1u;
}
DI void xcd_barrier(const XcdBarrier& b) {
  asm volatile("s_waitcnt vmcnt(0)" ::: "memory");
  __syncthreads();
  if (threadIdx.x == 0) {
    unsigned* bar = b.bar;
    __builtin_amdgcn_s_waitcnt(0);
    const unsigned nloc = b.nloc, nx = b.nx;
    const unsigned old = xb_add(&bar[XB_XSUB(b.x)], 1u);
    const unsigned gen = old / nloc;
    if (old + 1u == (gen + 1u) * nloc) {
      __builtin_amdgcn_fence(__ATOMIC_RELEASE, "agent");
      asm volatile("s_waitcnt vmcnt(0)" ::: "memory");
      const unsigned og = xb_add(&bar[XB_TOP], 1u);
      const unsigned tg = og / nx;
      if (og + 1u == (tg + 1u) * nx) xb_add(&bar[XB_TOPGEN], 1u);
      else XB_SPIN(xb_ld(&bar[XB_TOPGEN]) == tg, bar);
      __builtin_amdgcn_fence(__ATOMIC_ACQUIRE, "agent");
      xb_add(&bar[XB_XGEN(b.x)], 1u);
      asm volatile("s_waitcnt vmcnt(0)" ::: "memory");
    } else {
      XB_SPIN(xb_ld(&bar[XB_XGEN(b.x)]) == gen, bar);
      __builtin_amdgcn_fence(__ATOMIC_ACQUIRE, "agent");
      asm volatile("s_waitcnt vmcnt(0)" ::: "memory");
    }
  }
  __syncthreads();
}

constexpr int N_PHASES = 12;
template <int PH> DI void run_phase(const Params& p, lds_t* shm) {
  float* ssq = (float*)(p.ws + OFF_SSQ);
  if (PH == 0) prep_phase(p, shm);
  else if (PH == 1) {
    g8::gemm_phase<GSP2, GALIGN>(slot(p, 0), wt(p, W_IN), T_TOK, 7168, 1024, EpiProj{p}, shm);
    g8::gemm_phase<GSP2, GALIGN>((const bf16_t*)(p.ws + OFF_MEMN), wt(p, W_XKV), 1024, 2048, 1024, EpiPlainBf16{(bf16_t*)(p.ws + OFF_KVX), 2048}, shm);
  }
  else if (PH == 2) {}
  else if (PH == 3) { sg_phase(p, shm); diff_attn_phase(p, shm); }
  else if (PH == 4) merged_phase(p, shm);
  else if (PH == 5) g8::gemm_phase<GSP2, GALIGN>(slot(p, 1), wt(p, W_OUT), T_TOK, 1024, 1024, EpiResid{p.x, nullptr, nullptr, slot(p, 2), ssq}, shm);
  else if (PH == 6) { g8::gemm_phase<GSP2, GALIGN>(slot(p, 2), wt(p, W_XQ), T_TOK, 1024, 1024, EpiRowScale{slot(p, 3), 1024, ssq, 0.0625f * LOG2E, 0}, shm); cross_attn_own_tiles(p, shm); }
  else if (PH == 7) {}
  else if (PH == 8) g8::gemm_phase<GSP2, GALIGN>(slot(p, 0), wt(p, W_XO), T_TOK, 1024, 1024, EpiResid{nullptr, slot(p, 2), nullptr, slot(p, 1), ssq + T_TOK}, shm);
  else if (PH == 9) g8::gemm_phase<GSP2, GALIGN>(slot(p, 1), wt(p, W_FF1), T_TOK, 4096, 1024, EpiRowScale{slot(p, 2), 4096, ssq + T_TOK, 1.0f, 1}, shm);
  else if (PH == 10) {
    if (gridDim.x == 256) g8::gemm_phase<GSP2, true>(slot(p, 2), wt(p, W_FF2), T_TOK, 1024, 4096, EpiResidFinal{slot(p, 1), p.out, ssq + 2 * T_TOK, (unsigned*)(p.ws + OFF_BAR) + 3584, p.g_final}, shm);
    else g8::gemm_phase<GSP2, GALIGN>(slot(p, 2), wt(p, W_FF2), T_TOK, 1024, 4096, EpiResid{nullptr, slot(p, 1), p.out, nullptr, ssq + 2 * T_TOK}, shm);
  }
  else if (PH == 11) { if (gridDim.x != 256) final_phase(p); }
}

extern __shared__ __attribute__((aligned(16))) unsigned char smem_raw[];

#if !MK_COOP
template <int PH> __global__ void __launch_bounds__(NTHR) phase_kernel(Params p) { run_phase<PH>(p, (lds_t*)smem_raw); }
template <int PH> static void launch_phases(const Params& p, int grid, hipStream_t stream) {
  (void)hipFuncSetAttribute((const void*)phase_kernel<PH>, hipFuncAttributeMaxDynamicSharedMemorySize, SMEM_BYTES);
  hipLaunchKernelGGL(phase_kernel<PH>, dim3(grid), dim3(NTHR), SMEM_BYTES, stream, p);
  if constexpr (PH + 1 < N_PHASES) launch_phases<PH + 1>(p, grid, stream);
}
#else

template <int PH> DI void run_from(const Params& p, lds_t* shm, cg::grid_group& grid, const XcdBarrier& xb) {
  run_phase<PH>(p, shm);
  if constexpr (PH + 1 < N_PHASES) { if (PH != 2 && PH != 6 && !(PH == 10 && gridDim.x == 256)) xcd_barrier(xb); run_from<PH + 1>(p, shm, grid, xb); }
}
__global__ void __launch_bounds__(NTHR) mega_kernel(Params p) {
  cg::grid_group grid = cg::this_grid();
  if (p.ws == nullptr) grid.sync();
  XcdBarrier xb; xb.bar = (unsigned*)(p.ws + OFF_BAR); xb.x = xcd_barrier_post(xb.bar);
  { __attribute__((address_space(3))) unsigned* t = LDSP(unsigned, smem_raw);
    if (threadIdx.x == 0) { unsigned nloc, nx; xcd_barrier_complete(xb.bar, xb.x, nloc, nx); t[0] = nloc; t[1] = nx; }
    __syncthreads();
    xb.nloc = __builtin_amdgcn_readfirstlane(t[0]); xb.nx = __builtin_amdgcn_readfirstlane(t[1]);
    __syncthreads(); }
  run_from<0>(p, (lds_t*)smem_raw, grid, xb);
}

#endif

extern "C" void kernel_launch(void* const* d_in, const int* in_sizes, int n_in, void* d_out, int out_size, void* d_ws, size_t ws_size, hipStream_t stream) {
  Params p{};
  p.x = (const float*)d_in[0]; p.mem = (const float*)d_in[1]; p.pos = (const int*)d_in[2];
  p.g_mix = (const float*)d_in[3]; p.w_in = (const float*)d_in[4]; p.lq1 = (const float*)d_in[5]; p.lk1 = (const float*)d_in[6]; p.lq2 = (const float*)d_in[7]; p.lk2 = (const float*)d_in[8];
  p.g_subln = (const float*)d_in[9]; p.ln_g = (const float*)d_in[10]; p.ln_b = (const float*)d_in[11]; p.sg_w = (const float*)d_in[12]; p.sg_b = (const float*)d_in[13];
  p.w_ba = (const float*)d_in[14]; p.w_bs = (const float*)d_in[15]; p.w_out = (const float*)d_in[16]; p.g_xa = (const float*)d_in[17]; p.g_mem = (const float*)d_in[18];
  p.w_xq = (const float*)d_in[19]; p.w_xkv = (const float*)d_in[20]; p.w_xo = (const float*)d_in[21]; p.g_ffn = (const float*)d_in[22]; p.w_ff1 = (const float*)d_in[23]; p.w_ff2 = (const float*)d_in[24];
  p.g_final = (const float*)d_in[25]; p.out = (float*)d_out; p.ws = (unsigned char*)d_ws;
#if MK_COOP
  static int grid_blocks = 0;
  if (!grid_blocks) {
    int dev = 0, cus = 0, per_cu = 0; hipGetDevice(&dev); hipDeviceGetAttribute(&cus, hipDeviceAttributeMultiprocessorCount, dev);
    hipFuncSetAttribute((const void*)mega_kernel, hipFuncAttributeMaxDynamicSharedMemorySize, SMEM_BYTES);
    hipOccupancyMaxActiveBlocksPerMultiprocessor(&per_cu, mega_kernel, NTHR, SMEM_BYTES);
    if (per_cu < 1) per_cu = 1;
    grid_blocks = cus * per_cu;
  }
  (void)hipMemsetAsync((char*)d_ws + OFF_BAR, 0, 16384, stream);
  void* args[] = {&p};
  hipError_t e = hipLaunchCooperativeKernel((const void*)mega_kernel, dim3(grid_blocks), dim3(NTHR), args, SMEM_BYTES, stream);
  if (e != hipSuccess) fprintf(stderr, "cooperative launch failed: %s (grid %d)\n", hipGetErrorString(e), grid_blocks);
#else
  launch_phases<0>(p, 256, stream);
#endif
}
```
